# Optimizing an MI355X kernel written in HIP

```python
import jax
import jax.numpy as jnp
from jax import lax
import numpy as np

D_MODEL = 1024
BATCH = 4
SEQ = 8192
DEPTH = 1

PLE_DIM = 256
D_FF = 2816
N_HEADS = 8
N_KV_HEADS = 2
HEAD_DIM = 64
HEADS_PER_GROUP = N_HEADS // N_KV_HEADS
NSA_WIDTH = N_HEADS * HEAD_DIM
KV_WIDTH = N_KV_HEADS * HEAD_DIM
S5_WIDTH = D_MODEL - NSA_WIDTH
S5_GROUP = 16
S5_GROUPS = S5_WIDTH // S5_GROUP
S5_STATE = 64
CMP_LEN = 32
CMP_STRIDE = 16
CMP_HIDDEN = 256
SEL_BLOCK = 64
SEL_TOPK = 16
WINDOW = 512
Q_BLOCK = 128
ROPE_THETA = 10000.0
RMS_EPS = 1e-6
NEG = -1e30
BIG = 1e9
IN_COLS = NSA_WIDTH + 6 * KV_WIDTH + 3 * N_HEADS + S5_WIDTH

kernel_name = "hybrid_nsa_s5_macaron_block"


def rmsnorm(x, g):
    xf = x.astype(jnp.float32)
    y = xf * lax.rsqrt(jnp.mean(xf * xf, axis=-1, keepdims=True) + RMS_EPS)
    return (y * g.astype(jnp.float32)).astype(x.dtype)


def swiglu(x, w1, w3, w2):
    return (jax.nn.silu(x @ w1) * (x @ w3)) @ w2


def rope(x, pos):
    half = HEAD_DIM // 2
    inv = ROPE_THETA ** (-jnp.arange(half, dtype=jnp.float32) / half)
    ang = pos[:, None] * inv[None, :]
    cos = jnp.cos(ang)[None, :, None, :]
    sin = jnp.sin(ang)[None, :, None, :]
    xf = x.astype(jnp.float32)
    x1, x2 = xf[..., :half], xf[..., half:]
    return jnp.concatenate([x1 * cos - x2 * sin, x1 * sin + x2 * cos], axis=-1).astype(x.dtype)


def masked_softmax(s, mask):
    s = jnp.where(mask, s, NEG)
    m = jnp.max(s, axis=-1, keepdims=True)
    e = jnp.where(mask, jnp.exp(s - m), 0.0)
    return e / jnp.maximum(jnp.sum(e, axis=-1, keepdims=True), 1e-30)


def compress(kv, pe, w1, w2):
    B, L = kv.shape[:2]
    n_cmp = (L - CMP_LEN) // CMP_STRIDE + 1
    tok = jnp.arange(n_cmp)[:, None] * CMP_STRIDE + jnp.arange(CMP_LEN)[None, :]
    blk = kv[:, tok] + pe[None, None, :, None, :]
    blk = jnp.transpose(blk, (0, 1, 3, 2, 4)).reshape(B, n_cmp, N_KV_HEADS, CMP_LEN * HEAD_DIM)
    return jax.nn.gelu(blk @ w1) @ w2


def nsa_attention(q, k_cmp, v_cmp, k_slc, v_slc, k_win, v_win, gates, pe_k, pe_v, wk1, wk2, wv1, wv2):
    B, L = q.shape[:2]
    G, HPG, DK = N_KV_HEADS, HEADS_PER_GROUP, HEAD_DIM
    n_cmp = (L - CMP_LEN) // CMP_STRIDE + 1
    n_sel = L // SEL_BLOCK
    n_qb = L // Q_BLOCK
    top_k = min(SEL_TOPK, n_sel)
    scale = DK ** -0.5

    kc = compress(k_cmp, pe_k, wk1, wk2)
    vc = compress(v_cmp, pe_v, wv1, wv2)
    c_start = jnp.arange(n_cmp) * CMP_STRIDE
    c_end = c_start + CMP_LEN - 1
    s_start = jnp.arange(n_sel) * SEL_BLOCK
    overlap = ((c_start[:, None] < s_start[None, :] + SEL_BLOCK)
               & (c_start[:, None] + CMP_LEN > s_start[None, :])).astype(jnp.float32)

    ks_blk = jnp.transpose(k_slc.reshape(B, n_sel, SEL_BLOCK, G, DK), (0, 3, 1, 2, 4))
    vs_blk = jnp.transpose(v_slc.reshape(B, n_sel, SEL_BLOCK, G, DK), (0, 3, 1, 2, 4))
    kw_pad = jnp.pad(k_win, ((0, 0), (WINDOW, 0), (0, 0), (0, 0)))
    vw_pad = jnp.pad(v_win, ((0, 0), (WINDOW, 0), (0, 0), (0, 0)))
    b_ix = jnp.arange(B)[:, None, None, None]
    g_ix = jnp.arange(G)[None, :, None, None]
    blk_ids = jnp.arange(n_sel)

    q_blocks = jnp.transpose(q.reshape(B, n_qb, Q_BLOCK, G, HPG, DK), (1, 0, 2, 3, 4, 5))
    g_blocks = jnp.transpose(gates.reshape(B, n_qb, Q_BLOCK, G, HPG, 3), (1, 0, 2, 3, 4, 5))

    def one_block(args):
        c, qc, gc = args
        t = c * Q_BLOCK + jnp.arange(Q_BLOCK)
        s = jnp.einsum('bqghd,bcgd->bghqc', qc, kc).astype(jnp.float32) * scale
        p_cmp = masked_softmax(s, c_end[None, :] <= t[:, None])
        o_cmp = jnp.einsum('bghqc,bcgd->bqghd', p_cmp.astype(vc.dtype), vc)
        imp = jnp.einsum('bghqc,cs->bgqs', p_cmp, overlap)
        cur = (t // SEL_BLOCK)[:, None]
        valid = blk_ids[None, :] <= cur
        forced = (blk_ids[None, :] == 0) | (blk_ids[None, :] == cur) | (blk_ids[None, :] == cur - 1)
        score = jnp.where(valid & forced, BIG, jnp.where(valid, imp, -BIG))
        _, idx = lax.top_k(score, top_k)
        k_sel = ks_blk[b_ix, g_ix, idx]
        v_sel = vs_blk[b_ix, g_ix, idx].reshape(B, G, Q_BLOCK, top_k * SEL_BLOCK, DK)
        s = jnp.einsum('bqghd,bgqkrd->bghqkr', qc, k_sel).astype(jnp.float32) * scale
        s = s.reshape(B, G, HPG, Q_BLOCK, top_k * SEL_BLOCK)
        kpos = (idx[..., None] * SEL_BLOCK + jnp.arange(SEL_BLOCK)).reshape(B, G, 1, Q_BLOCK, top_k * SEL_BLOCK)
        p_slc = masked_softmax(s, kpos <= t[:, None])
        o_slc = jnp.einsum('bghqn,bgqnd->bqghd', p_slc.astype(v_sel.dtype), v_sel)
        start = c * Q_BLOCK
        k_w = lax.dynamic_slice_in_dim(kw_pad, start, WINDOW + Q_BLOCK, axis=1)
        v_w = lax.dynamic_slice_in_dim(vw_pad, start, WINDOW + Q_BLOCK, axis=1)
        spos = start - WINDOW + jnp.arange(WINDOW + Q_BLOCK)
        dist = t[:, None] - spos[None, :]
        wmask = (spos[None, :] >= 0) & (dist >= 0) & (dist < WINDOW)
        s = jnp.einsum('bqghd,bsgd->bghqs', qc, k_w).astype(jnp.float32) * scale
        p_win = masked_softmax(s, wmask)
        o_win = jnp.einsum('bghqs,bsgd->bqghd', p_win.astype(v_w.dtype), v_w)
        o = gc[..., 0:1] * o_cmp + gc[..., 1:2] * o_slc + gc[..., 2:3] * o_win
        return o.astype(qc.dtype)

    out = lax.map(one_block, (jnp.arange(n_qb), q_blocks, g_blocks))
    return jnp.transpose(out, (1, 0, 2, 3, 4, 5)).reshape(B, L, NSA_WIDTH)


def s5_mixer(u, a_re, a_im, log_dt, b_re, b_im, c_re, c_im, d_skip, w_glu, b_glu):
    B, L = u.shape[:2]
    f32 = jnp.float32
    uf = u.astype(f32).reshape(B, L, S5_GROUPS, S5_GROUP)
    lam = lax.complex(a_re.astype(f32), a_im.astype(f32))
    dt = jnp.exp(log_dt.astype(f32))[:, None]
    a_bar = jnp.exp(lam * dt)
    b_coef = (a_bar - 1.0) / lam
    bu_re = jnp.einsum('blgi,gni->blgn', uf, b_re.astype(f32))
    bu_im = jnp.einsum('blgi,gni->blgn', uf, b_im.astype(f32))
    bu = lax.complex(bu_re, bu_im) * b_coef
    a_seq = jnp.broadcast_to(a_bar, (1, L) + a_bar.shape)

    def combine(e1, e2):
        a1, x1 = e1
        a2, x2 = e2
        return a2 * a1, a2 * x1 + x2

    _, state = lax.associative_scan(combine, (a_seq, bu), axis=1)
    y = (jnp.einsum('blgn,gon->blgo', jnp.real(state), c_re.astype(f32))
         - jnp.einsum('blgn,gon->blgo', jnp.imag(state), c_im.astype(f32))
         + d_skip.astype(f32) * uf)
    y = jax.nn.gelu(y.reshape(B, L, S5_WIDTH))
    out = y * jax.nn.sigmoid(y @ w_glu.astype(f32) + b_glu.astype(f32))
    return out.astype(u.dtype)


def setup_inputs(seed: int = 0) -> dict:
    key = jax.random.key(seed)
    ks = jax.random.split(key, 40)
    f32 = jnp.float32

    def nrm(k, shape, fan_in):
        return jax.random.normal(k, shape, f32) * (fan_in ** -0.5)

    def gain(k, shape):
        return 1.0 + 0.05 * jax.random.normal(k, shape, f32)

    n_idx = jnp.arange(S5_STATE, dtype=f32)
    return {
        "x": jax.random.normal(ks[0], (BATCH, SEQ, D_MODEL), f32),
        "p": jax.random.normal(ks[1], (DEPTH, BATCH, SEQ, PLE_DIM), f32),
        "norm_ffn1": gain(ks[2], (DEPTH, D_MODEL)),
        "ffn1_w1": nrm(ks[3], (DEPTH, D_MODEL, D_FF), D_MODEL),
        "ffn1_w3": nrm(ks[4], (DEPTH, D_MODEL, D_FF), D_MODEL),
        "ffn1_w2": nrm(ks[5], (DEPTH, D_FF, D_MODEL), D_FF),
        "norm_mix": gain(ks[6], (DEPTH, D_MODEL)),
        "w_in": nrm(ks[7], (DEPTH, D_MODEL, IN_COLS), D_MODEL),
        "cmp_pe_k": 0.1 * jax.random.normal(ks[8], (DEPTH, CMP_LEN, HEAD_DIM), f32),
        "cmp_pe_v": 0.1 * jax.random.normal(ks[9], (DEPTH, CMP_LEN, HEAD_DIM), f32),
        "cmp_wk1": nrm(ks[10], (DEPTH, CMP_LEN * HEAD_DIM, CMP_HIDDEN), CMP_LEN * HEAD_DIM),
        "cmp_wk2": nrm(ks[11], (DEPTH, CMP_HIDDEN, HEAD_DIM), CMP_HIDDEN),
        "cmp_wv1": nrm(ks[12], (DEPTH, CMP_LEN * HEAD_DIM, CMP_HIDDEN), CMP_LEN * HEAD_DIM),
        "cmp_wv2": nrm(ks[13], (DEPTH, CMP_HIDDEN, HEAD_DIM), CMP_HIDDEN),
        "s5_a_re": -0.5 + 0.01 * jax.random.normal(ks[14], (DEPTH, S5_GROUPS, S5_STATE), f32),
        "s5_a_im": jnp.pi * n_idx + 0.01 * jax.random.normal(ks[15], (DEPTH, S5_GROUPS, S5_STATE), f32),
        "s5_log_dt": jax.random.uniform(ks[16], (DEPTH, S5_GROUPS), f32, jnp.log(0.001), jnp.log(0.1)),
        "s5_b_re": nrm(ks[17], (DEPTH, S5_GROUPS, S5_STATE, S5_GROUP), 2 * S5_GROUP),
        "s5_b_im": nrm(ks[18], (DEPTH, S5_GROUPS, S5_STATE, S5_GROUP), 2 * S5_GROUP),
        "s5_c_re": nrm(ks[19], (DEPTH, S5_GROUPS, S5_GROUP, S5_STATE), S5_STATE),
        "s5_c_im": nrm(ks[20], (DEPTH, S5_GROUPS, S5_GROUP, S5_STATE), S5_STATE),
        "s5_d": jax.random.normal(ks[21], (DEPTH, S5_GROUPS, S5_GROUP), f32),
        "s5_w_glu": nrm(ks[22], (DEPTH, S5_WIDTH, S5_WIDTH), S5_WIDTH),
        "s5_b_glu": 0.01 * jax.random.normal(ks[23], (DEPTH, S5_WIDTH), f32),
        "w_out": nrm(ks[24], (DEPTH, D_MODEL, D_MODEL), D_MODEL),
        "norm_ffn2": gain(ks[25], (DEPTH, D_MODEL)),
        "ffn2_w1": nrm(ks[26], (DEPTH, D_MODEL, D_FF), D_MODEL),
        "ffn2_w3": nrm(ks[27], (DEPTH, D_MODEL, D_FF), D_MODEL),
        "ffn2_w2": nrm(ks[28], (DEPTH, D_FF, D_MODEL), D_FF),
        "norm_ple": gain(ks[29], (DEPTH, D_MODEL)),
        "w_ple_gate": nrm(ks[30], (DEPTH, D_MODEL, D_MODEL), D_MODEL),
        "w_ple": nrm(ks[31], (DEPTH, PLE_DIM, D_MODEL), PLE_DIM),
        "norm_final": gain(ks[32], (D_MODEL,)),
    }


def reference(x, p, norm_ffn1, ffn1_w1, ffn1_w3, ffn1_w2, norm_mix, w_in,
              cmp_pe_k, cmp_pe_v, cmp_wk1, cmp_wk2, cmp_wv1, cmp_wv2,
              s5_a_re, s5_a_im, s5_log_dt, s5_b_re, s5_b_im, s5_c_re, s5_c_im, s5_d,
              s5_w_glu, s5_b_glu, w_out, norm_ffn2, ffn2_w1, ffn2_w3, ffn2_w2,
              norm_ple, w_ple_gate, w_ple, norm_final):
    B, L = x.shape[:2]
    pos = jnp.arange(L, dtype=jnp.float32)
    split_at = [NSA_WIDTH + k * KV_WIDTH for k in range(7)] + [NSA_WIDTH + 6 * KV_WIDTH + 3 * N_HEADS]
    h = x
    for i in range(DEPTH):
        h = h + 0.5 * swiglu(rmsnorm(h, norm_ffn1[i]), ffn1_w1[i], ffn1_w3[i], ffn1_w2[i])
        z = rmsnorm(h, norm_mix[i]) @ w_in[i]
        q, kc, vc, ksl, vsl, kw, vw, g, u = jnp.split(z, split_at, axis=-1)
        kvshape = (B, L, N_KV_HEADS, HEAD_DIM)
        q = rope(q.reshape(B, L, N_HEADS, HEAD_DIM), pos)
        kc = rope(kc.reshape(kvshape), pos)
        ksl = rope(ksl.reshape(kvshape), pos)
        kw = rope(kw.reshape(kvshape), pos)
        gates = jax.nn.sigmoid(g.reshape(B, L, N_HEADS, 3))
        o_nsa = nsa_attention(q, kc, vc.reshape(kvshape), ksl, vsl.reshape(kvshape), kw, vw.reshape(kvshape),
                              gates, cmp_pe_k[i], cmp_pe_v[i], cmp_wk1[i], cmp_wk2[i], cmp_wv1[i], cmp_wv2[i])
        o_s5 = s5_mixer(u, s5_a_re[i], s5_a_im[i], s5_log_dt[i], s5_b_re[i], s5_b_im[i],
                        s5_c_re[i], s5_c_im[i], s5_d[i], s5_w_glu[i], s5_b_glu[i])
        h = h + jnp.concatenate([o_nsa, o_s5], axis=-1) @ w_out[i]
        h = h + 0.5 * swiglu(rmsnorm(h, norm_ffn2[i]), ffn2_w1[i], ffn2_w3[i], ffn2_w2[i])
        gate = jax.nn.sigmoid(rmsnorm(h, norm_ple[i]) @ w_ple_gate[i])
        h = h + gate * (p[i] @ w_ple[i])
    return rmsnorm(h, norm_final)
```

```cpp
#include <hip/hip_runtime.h>
#include <hip/hip_cooperative_groups.h>
#include <cstdio>
#include <cstdint>
namespace cg = cooperative_groups;

#define LAS __attribute__((address_space(3)))
#define DI __device__ __forceinline__
typedef unsigned short bf16_t;
typedef short bf16x8 __attribute__((ext_vector_type(8)));
typedef short s16x4 __attribute__((ext_vector_type(4)));
typedef float f32x4 __attribute__((ext_vector_type(4)));
typedef float f32x2 __attribute__((ext_vector_type(2)));
typedef float f32x16 __attribute__((ext_vector_type(16)));
typedef unsigned u32x4 __attribute__((ext_vector_type(4)));
typedef unsigned u32x2 __attribute__((ext_vector_type(2)));
typedef __bf16 bf16x2_t __attribute__((ext_vector_type(2)));

constexpr int TT = 32768, SEQ = 8192, DM = 1024, DFF = 2816;
constexpr float RMS_EPS = 1e-6f;
constexpr float QC2 = 0.125f * 1.4426950408889634f;
constexpr float LOG2E = 1.4426950408889634f;

constexpr size_t MiB = 1u << 20;
constexpr size_t WS_COS = 1 * MiB, WS_SIN = 2 * MiB, WS_SS = 3 * MiB, WS_KR = 5 * MiB, WS_A64 = 7 * MiB, WS_BIAS = 7 * MiB + 65536, WS_BIASP = 456 * MiB;
constexpr size_t WS_W13A = 8 * MiB, WS_W2A = 19 * MiB, WS_W13B = 25 * MiB, WS_W2B = 36 * MiB, WS_WIN = 42 * MiB, WS_WOUT = 46 * MiB, WS_WG = 48 * MiB;
constexpr size_t WS_WPLE = 50 * MiB, WS_WGLU = 50 * MiB + 524288, WS_WK1 = 51 * MiB, WS_WV1 = 52 * MiB, WS_WK2 = 53 * MiB, WS_WV2 = 53 * MiB + 65536;
constexpr size_t WS_PB = 54 * MiB, WS_HB = 70 * MiB, WS_OC = 134 * MiB, WS_TT = 198 * MiB, WS_PT = 270 * MiB, WS_E = 198 * MiB;
constexpr size_t WS_ACT = 280 * MiB;
constexpr size_t WS_Q = 280 * MiB, WS_KC = 312 * MiB, WS_VC = 320 * MiB, WS_KS = 329 * MiB, WS_VS = 337 * MiB, WS_KW = 345 * MiB, WS_VW = 353 * MiB;
constexpr size_t WS_GATES = 361 * MiB, WS_AEXT = 364 * MiB, WS_SLOC = 400 * MiB, WS_HC = 408 * MiB, WS_KCMP = 412 * MiB, WS_VCMP = 412 * MiB + 524288, WS_YP = 413 * MiB;
constexpr size_t WS_END = 459 * MiB; constexpr size_t WS_SS2 = 457 * MiB;

DI unsigned cvtpk(float lo, float hi) { f32x2 v = {lo, hi}; bf16x2_t b = __builtin_convertvector(v, bf16x2_t); return __builtin_bit_cast(unsigned, b); }
DI float sigmoidf_(float x) { return __builtin_amdgcn_rcpf(1.f + __builtin_amdgcn_exp2f(-x * LOG2E)); }
DI float gelu_tanh(float x) { const float u = x + 0.044715f * x * x * x; return x * __builtin_amdgcn_rcpf(1.f + __builtin_amdgcn_exp2f(-2.f * 0.7978845608028654f * LOG2E * u)); }
DI float bf2f(bf16_t v) { return __uint_as_float((unsigned)v << 16); }

namespace pg8 {
constexpr int BM = 256, BK = 64, HALF = 128, HTB = HALF * BK * 2, STAGE_BYTES = 8 * HTB, NXCD = 8, WGM = 8;
DI int lds_byte(int r, int c) { const int st = (r >> 4) * 2 + (c >> 5), rr = r & 15, cc = c & 31, ob = rr * 64 + cc * 2; return st * 1024 + (ob ^ (((ob >> 9) & 1) << 5)); }
DI void stage_rc(int b, int& R, int& C) { const int st = b / 1024, sb = b % 1024, swz = sb ^ (((sb >> 9) & 1) << 5); R = (st >> 1) * 16 + swz / 64; C = (st & 1) * 32 + (swz % 64) / 2; }
DI int perm32(int rho) { const int n = rho >> 4, i = rho & 15; return 8 * (i >> 2) + 4 * n + (i & 3); }

struct Unit { int pm, pn, ar, br, g, nt; };
struct Gemm { const bf16_t* A; const bf16_t* Bt; int K, lda, ldb; size_t ksA = 128; };

struct SchedGrid {
    int nM, nN, nwg, G, c;
    DI void init(int M, int N, int G_, int c_) { nM = M / BM; nN = N / BM; nwg = nM * nN; G = G_; c = c_; }
    DI bool next(int i, Unit& u) const {
        const long L = (long)i * G + c; if (L >= nwg) return false;
        int wgid = (int)L; { const int q = nwg / NXCD, r = nwg % NXCD, xcd = wgid % NXCD, off = wgid / NXCD; wgid = (xcd < r ? xcd * (q + 1) : r * (q + 1) + (xcd - r) * q) + off; }
        const int nig = WGM * nN, gid = wgid / nig, fm = gid * WGM, gsz = (nM - fm) < WGM ? (nM - fm) : WGM;
        u.pm = fm + ((wgid % nig) % gsz); u.pn = (wgid % nig) / gsz; u.ar = u.pm * BM; u.br = u.pn * BM; u.g = 0; u.nt = 0; return true;
    }
};
struct SchedBatch {
    int nb, mt, nt, aStride, bStride, G, c, ktrim = 0;
    DI bool next(int i, Unit& u) const {
        const int L = i * G + c; if (L >= nb * mt * nt) return false;
        const int g = L / (mt * nt), r = L % (mt * nt); u.g = g; u.pm = r % mt; u.pn = r / mt; u.ar = g * aStride + u.pm * BM; u.br = g * bStride + u.pn * BM; u.nt = ktrim ? 2 + 4 * (u.pn + 1) : 0; return true;
    }
};

template <class Epi, class Sched, bool ALIGN_EPI>
DI void gemm_phase(LAS unsigned char* lds, const Gemm g, const Sched& S, const Epi& E) {
    int tid = threadIdx.x; asm volatile("" : "+v"(tid));
    const int wid = __builtin_amdgcn_readfirstlane(tid >> 6), lane = tid & 63, wr = wid >> 2, wc = wid & 3, fr = lane & 15, fq = lane >> 4;
    const int K = g.K, ntdef = K / BK; int nt = ntdef;
    unsigned voffA[2], voffB[2];
#pragma unroll
    for (int i = 0; i < 2; ++i) { int R, C; stage_rc(tid * 16 + i * 8192, R, C); const int Rb = (R & ~31) + perm32(R & 31);
        voffA[i] = (unsigned)(R * g.lda + C) * 2u; voffB[i] = (unsigned)(Rb * g.ldb + C) * 2u; }
    const size_t kstep = (size_t)(BK * 2), kstepA = g.ksA;
    const size_t hstepA = (size_t)HALF * g.lda * 2, hstepB = (size_t)HALF * g.ldb * 2;
    const unsigned ldsw = (unsigned)wid * 1024u;
    const int aoff = lds_byte(wr * 64 + fr, fq * 8), boff = lds_byte(wc * 32 + fr, fq * 8);
#define PG8_SA(b, h) (((b) * 2 + (h)) * HTB)
#define PG8_SB(b, h) ((4 + (b) * 2 + (h)) * HTB)
#define PG8_STAGE(bufoff, gbase, voff) do { _Pragma("unroll") for (int _i = 0; _i < 2; ++_i) \
        __builtin_amdgcn_global_load_lds((const unsigned*)((const char*)(gbase) + (voff)[_i]), (LAS unsigned*)(lds + (bufoff) + ldsw + _i * 8192), 16, 0, 0); } while (0)
#define PG8_LDA(dst, b, h) do { _Pragma("unroll") for (int m = 0; m < 4; ++m) _Pragma("unroll") for (int k = 0; k < 2; ++k) dst[m][k] = *(const LAS bf16x8*)(lds + PG8_SA(b, h) + aoff + m * 2048 + k * 1024); } while (0)
#define PG8_LDB(dst, b, h) do { _Pragma("unroll") for (int n = 0; n < 2; ++n) _Pragma("unroll") for (int k = 0; k < 2; ++k) dst[n][k] = *(const LAS bf16x8*)(lds + PG8_SB(b, h) + boff + n * 2048 + k * 1024); } while (0)
#define PG8_MMA(ai, bj, At, Bt) do { __builtin_amdgcn_s_setprio(1); _Pragma("unroll") for (int m = 0; m < 4; ++m) _Pragma("unroll") for (int n = 0; n < 2; ++n) _Pragma("unroll") for (int k = 0; k < 2; ++k) \
        acc[ai][bj][m][n] = __builtin_amdgcn_mfma_f32_16x16x32_bf16(Bt[n][k], At[m][k], acc[ai][bj][m][n], 0, 0, 0); __builtin_amdgcn_s_setprio(0); } while (0)
#define PG8_WAIT_V(n) asm volatile("s_waitcnt vmcnt(" #n ")" ::: "memory")
#define PG8_WAIT_L(n) asm volatile("s_waitcnt lgkmcnt(" #n ")" ::: "memory")
#define PG8_BAR __builtin_amdgcn_s_barrier()
#define PG8_SCHED __builtin_amdgcn_sched_barrier(0)
    Unit cur, nxt; int ui = 0;
    if (!S.next(0, cur)) return;
    nt = cur.nt ? cur.nt : ntdef;
    f32x4 acc[2][2][4][2];
#pragma unroll
    for (int a = 0; a < 2; ++a)
#pragma unroll
        for (int b = 0; b < 2; ++b)
#pragma unroll
            for (int m = 0; m < 4; ++m)
#pragma unroll
                for (int n = 0; n < 2; ++n) acc[a][b][m][n] = (f32x4){0.f, 0.f, 0.f, 0.f};
    bf16x8 At[4][2], B0[2][2], B1[2][2];
    const char* cA = (const char*)g.A + (size_t)cur.ar * g.lda * 2; const char* cB = (const char*)g.Bt + (size_t)cur.br * g.ldb * 2;
    PG8_STAGE(PG8_SB(0, 0), cB, voffB); PG8_STAGE(PG8_SB(0, 1), cB + hstepB, voffB); PG8_STAGE(PG8_SA(0, 0), cA, voffA); PG8_STAGE(PG8_SA(0, 1), cA + hstepA, voffA);
    if (wr == 1) PG8_BAR;
    PG8_WAIT_V(2); PG8_BAR;
    PG8_STAGE(PG8_SB(1, 0), cB + kstep, voffB); PG8_STAGE(PG8_SA(1, 0), cA + kstepA, voffA); PG8_STAGE(PG8_SB(1, 1), cB + hstepB + kstep, voffB);
    PG8_WAIT_V(6); PG8_BAR;
    for (;;) {
        const bool has_next = S.next(ui + 1, nxt);
        const char* nA = has_next ? (const char*)g.A + (size_t)nxt.ar * g.lda * 2 : cA; const char* nB = has_next ? (const char*)g.Bt + (size_t)nxt.br * g.ldb * 2 : cB;
        for (int t = 0; t < nt; t += 2) {
            const bool last = (t == nt - 2);
            const char* a1 = cA + (size_t)(t + 1) * kstepA;
            const char* a2 = last ? nA : cA + (size_t)(t + 2) * kstepA; const char* b2 = last ? nB : cB + (size_t)(t + 2) * kstep;
            const char* a3 = a2 + kstepA; const char* b3 = b2 + kstep;
            PG8_LDB(B0, 0, 0); PG8_LDB(B1, 0, 1); PG8_SCHED; PG8_LDA(At, 0, 0); PG8_STAGE(PG8_SA(1, 1), a1 + hstepA, voffA);
            PG8_WAIT_V(8); PG8_WAIT_L(0); PG8_BAR; PG8_MMA(0, 0, At, B0); PG8_MMA(0, 1, At, B1); PG8_BAR; PG8_SCHED;
            PG8_LDA(At, 0, 1); PG8_STAGE(PG8_SB(0, 0), b2, voffB); PG8_STAGE(PG8_SB(0, 1), b2 + hstepB, voffB); PG8_STAGE(PG8_SA(0, 0), a2, voffA);
            PG8_WAIT_V(8); PG8_WAIT_L(0); PG8_BAR; PG8_MMA(1, 0, At, B0); PG8_MMA(1, 1, At, B1); PG8_BAR; PG8_SCHED;
            PG8_LDB(B0, 1, 0); PG8_LDB(B1, 1, 1); PG8_SCHED; PG8_LDA(At, 1, 0); PG8_STAGE(PG8_SA(0, 1), a2 + hstepA, voffA);
            PG8_WAIT_V(8); PG8_WAIT_L(0); PG8_BAR; PG8_MMA(0, 0, At, B0); PG8_MMA(0, 1, At, B1); PG8_BAR; PG8_SCHED;
            PG8_LDA(At, 1, 1); PG8_STAGE(PG8_SB(1, 0), b3, voffB); PG8_STAGE(PG8_SB(1, 1), b3 + hstepB, voffB); PG8_STAGE(PG8_SA(1, 0), a3, voffA);
            PG8_WAIT_V(8); PG8_WAIT_L(0); PG8_BAR; PG8_MMA(1, 0, At, B0); PG8_MMA(1, 1, At, B1); PG8_BAR; PG8_SCHED;
        }
        if constexpr (ALIGN_EPI) { if (wr == 0) PG8_BAR; }
        E(acc, cur, wr, wc, fr, fq);
        if (!has_next) break;
#pragma unroll
        for (int a = 0; a < 2; ++a)
#pragma unroll
            for (int b = 0; b < 2; ++b)
#pragma unroll
                for (int m = 0; m < 4; ++m)
#pragma unroll
                    for (int n = 0; n < 2; ++n) acc[a][b][m][n] = (f32x4){0.f, 0.f, 0.f, 0.f};
        cur = nxt; cA = nA; cB = nB; ++ui; nt = cur.nt ? cur.nt : ntdef;
        if constexpr (ALIGN_EPI) { if (wr == 1) PG8_BAR; }
    }
    PG8_WAIT_V(0);
    if constexpr (!ALIGN_EPI) { if (wr == 0) PG8_BAR; }
    PG8_BAR;
#undef PG8_SA
#undef PG8_SB
#undef PG8_STAGE
#undef PG8_LDA
#undef PG8_LDB
#undef PG8_MMA
#undef PG8_WAIT_V
#undef PG8_WAIT_L
#undef PG8_BAR
#undef PG8_SCHED
}
}
using pg8::Unit;
typedef f32x4 AccT[2][2][4][2];

DI void load_rowscales(const float* SS, int row0, int fq, float (&rs)[2][4]) {
#pragma unroll
    for (int ai = 0; ai < 2; ++ai)
#pragma unroll
        for (int m = 0; m < 4; ++m) { const int row = row0 + ai * 128 + m * 16; const float* p = SS + (size_t)(4 * fq) * TT + row;
            float s = (p[0] + p[TT]) + (p[2 * (size_t)TT] + p[3 * (size_t)TT]); s += __shfl_xor(s, 16); s += __shfl_xor(s, 32);
            rs[ai][m] = rsqrtf(s * (1.f / 1024.f) + RMS_EPS); }
}
DI u32x4 pack8(const f32x4 a, const f32x4 b) { u32x4 w; w.x = cvtpk(a[0], a[1]); w.y = cvtpk(a[2], a[3]); w.z = cvtpk(b[0], b[1]); w.w = cvtpk(b[2], b[3]); return w; }

struct EpiSwiGLU { bf16_t* ACT; const float* SS; LAS unsigned char* lds;
    DI void operator()(const AccT& acc, const Unit& u, int wr, int wc, int fr, int fq) const {
        LAS float* rt = (LAS float*)(lds + 131072); volatile LAS int* tag = (volatile LAS int*)(lds + 131072 + 1024);
        const int tid = (wr * 4 + wc) * 64 + fq * 16 + fr;
        if (tag[0] != u.pm) {
            if (tid < 256) { const float* p = SS + (size_t)u.pm * 256 + tid; float sum = 0.f;
#pragma unroll
                for (int k = 0; k < 16; ++k) sum += p[(size_t)k * TT];
                rt[tid] = rsqrtf(sum * (1.f / 1024.f) + RMS_EPS); }
            asm volatile("s_waitcnt lgkmcnt(0)" ::: "memory"); __builtin_amdgcn_s_barrier(); asm volatile("" ::: "memory");
            if (tid == 0) tag[0] = u.pm;
        }
        const int row0 = u.pm * 256 + wr * 64 + fr;
        const int col = u.pn * 128 + wc * 32 + 8 * fq;
#pragma unroll
        for (int ai = 0; ai < 2; ++ai)
#pragma unroll
            for (int m = 0; m < 4; ++m) { const int row = row0 + ai * 128 + m * 16; const float r = rt[ai * 128 + wr * 64 + m * 16 + fr]; f32x4 o[2];
#pragma unroll
                for (int n = 0; n < 2; ++n)
#pragma unroll
                    for (int e = 0; e < 4; ++e) { const float gg = acc[ai][0][m][n][e] * r, uu = acc[ai][1][m][n][e] * r; o[n][e] = gg * sigmoidf_(gg) * uu; }
                *(u32x4*)(ACT + ((size_t)(col >> 6) * TT + row) * 64 + (col & 63)) = pack8(o[0], o[1]); }
    }
};
DI void unpack8(const u32x4 w, f32x4& a, f32x4& b) { a[0] = __uint_as_float(w.x << 16); a[1] = __uint_as_float(w.x & 0xffff0000u); a[2] = __uint_as_float(w.y << 16); a[3] = __uint_as_float(w.y & 0xffff0000u);
    b[0] = __uint_as_float(w.z << 16); b[1] = __uint_as_float(w.z & 0xffff0000u); b[2] = __uint_as_float(w.w << 16); b[3] = __uint_as_float(w.w & 0xffff0000u); }
DI float sumsq8(const f32x4 v0, const f32x4 v1) { return (v0[0] * v0[0] + v0[1] * v0[1]) + (v0[2] * v0[2] + v0[3] * v0[3]) + (v1[0] * v1[0] + v1[1] * v1[1]) + (v1[2] * v1[2] + v1[3] * v1[3]); }
template <bool BASEF32> struct EpiResid { const float* basef; bf16_t* Hb; float* SSout; float alpha;
    DI void operator()(const AccT& acc, const Unit& u, int wr, int wc, int fr, int fq) const {
        const int row0 = u.pm * 256 + wr * 64 + fr; const int colb = u.pn * 256 + wc * 32 + 8 * fq;
#pragma unroll
        for (int ai = 0; ai < 2; ++ai)
#pragma unroll
        for (int mh = 0; mh < 2; ++mh) {
            f32x4 pf0[2][2], pf1[2][2]; u32x4 ph[2][2];
#pragma unroll
            for (int mm = 0; mm < 2; ++mm)
#pragma unroll
                for (int bj = 0; bj < 2; ++bj) { const size_t off = (size_t)(row0 + ai * 128 + (2 * mh + mm) * 16) * DM + colb + bj * 128;
                    if (BASEF32) { pf0[mm][bj] = *(const f32x4*)(basef + off); pf1[mm][bj] = *(const f32x4*)(basef + off + 4); } else ph[mm][bj] = *(const u32x4*)(Hb + off); }
#pragma unroll
            for (int mm = 0; mm < 2; ++mm) { const int m = 2 * mh + mm; const int row = row0 + ai * 128 + m * 16; float q = 0.f;
#pragma unroll
                for (int bj = 0; bj < 2; ++bj) { const size_t off = (size_t)row * DM + colb + bj * 128; f32x4 b0, b1;
                    if (BASEF32) { b0 = pf0[mm][bj]; b1 = pf1[mm][bj]; } else unpack8(ph[mm][bj], b0, b1);
                    const f32x4 v0 = b0 + acc[ai][bj][m][0] * alpha, v1 = b1 + acc[ai][bj][m][1] * alpha;
                    *(u32x4*)(Hb + off) = pack8(v0, v1); q += sumsq8(v0, v1); }
                q += __shfl_xor(q, 16); q += __shfl_xor(q, 32);
                if (fq == 0) SSout[(size_t)(u.pn * 4 + wc) * TT + row] = q; }
        }
    }
};
struct EpiGate { const float* SS; const bf16_t* Eb; const bf16_t* Hb; bf16_t* H4; float* SSout;
    DI void operator()(const AccT& acc, const Unit& u, int wr, int wc, int fr, int fq) const {
        float rs[2][4]; const int row0 = u.pm * 256 + wr * 64 + fr; load_rowscales(SS, row0, fq, rs); const int colb = u.pn * 256 + wc * 32 + 8 * fq;
#pragma unroll
        for (int ai = 0; ai < 2; ++ai)
#pragma unroll
        for (int mh = 0; mh < 2; ++mh) {
            u32x4 pe[2][2], ph[2][2];
#pragma unroll
            for (int mm = 0; mm < 2; ++mm)
#pragma unroll
                for (int bj = 0; bj < 2; ++bj) { const size_t off = (size_t)(row0 + ai * 128 + (2 * mh + mm) * 16) * DM + colb + bj * 128; pe[mm][bj] = *(const u32x4*)(Eb + off); ph[mm][bj] = *(const u32x4*)(Hb + off); }
#pragma unroll
            for (int mm = 0; mm < 2; ++mm) { const int m = 2 * mh + mm; const int row = row0 + ai * 128 + m * 16; const float r = rs[ai][m]; float q = 0.f;
#pragma unroll
                for (int bj = 0; bj < 2; ++bj) { const size_t off = (size_t)row * DM + colb + bj * 128;
                    f32x4 e0, e1, b0, b1; unpack8(pe[mm][bj], e0, e1); unpack8(ph[mm][bj], b0, b1);
#pragma unroll
                    for (int e = 0; e < 4; ++e) { b0[e] += sigmoidf_(acc[ai][bj][m][0][e] * r) * e0[e]; b1[e] += sigmoidf_(acc[ai][bj][m][1][e] * r) * e1[e]; }
                    *(u32x4*)(H4 + off) = pack8(b0, b1); q += sumsq8(b0, b1); }
                q += __shfl_xor(q, 16); q += __shfl_xor(q, 32);
                if (fq == 0) SSout[(size_t)(u.pn * 4 + wc) * TT + row] = q; }
        }
    }
};
struct EpiGateNorm { const float* SS; const bf16_t* Eb; const bf16_t* Hb; float* out; const float* gfin; float* part; unsigned* cnt; LAS unsigned char* lds;
    DI void operator()(AccT& acc, const Unit& u, int wr, int wc, int fr, int fq) const {
        float rs[2][4]; const int row0 = u.pm * 256 + wr * 64 + fr; load_rowscales(SS, row0, fq, rs); const int colb = u.pn * 256 + wc * 32 + 8 * fq;
        LAS float* red = (LAS float*)(lds + 131072); LAS float* rf = red + 1024;
        const int tid = (wr * 4 + wc) * 64 + fq * 16 + fr;
#pragma unroll
        for (int ai = 0; ai < 2; ++ai)
#pragma unroll
        for (int mh = 0; mh < 2; ++mh) {
            u32x4 pe[2][2], ph[2][2];
#pragma unroll
            for (int mm = 0; mm < 2; ++mm)
#pragma unroll
                for (int bj = 0; bj < 2; ++bj) { const size_t off = (size_t)(row0 + ai * 128 + (2 * mh + mm) * 16) * DM + colb + bj * 128; pe[mm][bj] = *(const u32x4*)(Eb + off); ph[mm][bj] = *(const u32x4*)(Hb + off); }
#pragma unroll
            for (int mm = 0; mm < 2; ++mm) { const int m = 2 * mh + mm; const float r = rs[ai][m]; float q = 0.f;
#pragma unroll
                for (int bj = 0; bj < 2; ++bj) { f32x4 e0, e1, b0, b1; unpack8(pe[mm][bj], e0, e1); unpack8(ph[mm][bj], b0, b1);
#pragma unroll
                    for (int e = 0; e < 4; ++e) { b0[e] += sigmoidf_(acc[ai][bj][m][0][e] * r) * e0[e]; b1[e] += sigmoidf_(acc[ai][bj][m][1][e] * r) * e1[e]; }
                    acc[ai][bj][m][0] = b0; acc[ai][bj][m][1] = b1; q += sumsq8(b0, b1); }
                q += __shfl_xor(q, 16); q += __shfl_xor(q, 32);
                if (fq == 0) red[(ai * 128 + wr * 64 + m * 16 + fr) * 4 + wc] = q; }
        }
        asm volatile("s_waitcnt lgkmcnt(0)" ::: "memory"); __builtin_amdgcn_s_barrier(); asm volatile("" ::: "memory");
        if (tid < 256) { const float s4 = (red[tid * 4] + red[tid * 4 + 1]) + (red[tid * 4 + 2] + red[tid * 4 + 3]);
            __hip_atomic_store(part + (size_t)u.pn * TT + u.pm * 256 + tid, s4, __ATOMIC_RELAXED, __HIP_MEMORY_SCOPE_AGENT); }
        asm volatile("s_waitcnt vmcnt(0) lgkmcnt(0)" ::: "memory"); __builtin_amdgcn_s_barrier(); asm volatile("" ::: "memory");
        if (tid == 0) { unsigned* c = cnt + u.pm * 16; __hip_atomic_fetch_add(c, 1u, __ATOMIC_RELAXED, __HIP_MEMORY_SCOPE_AGENT);
            unsigned sp = 0; while (__hip_atomic_load(c, __ATOMIC_RELAXED, __HIP_MEMORY_SCOPE_AGENT) < 4u) { __builtin_amdgcn_s_sleep(2); if (++sp > (1u << 22)) break; }
            __builtin_amdgcn_fence(__ATOMIC_ACQUIRE, "agent"); asm volatile("s_waitcnt vmcnt(0)" ::: "memory"); }
        asm volatile("s_waitcnt vmcnt(0) lgkmcnt(0)" ::: "memory"); __builtin_amdgcn_s_barrier(); asm volatile("" ::: "memory");
        if (tid < 256) { float s4 = 0.f;
#pragma unroll
            for (int k = 0; k < 4; ++k) s4 += __hip_atomic_load(part + (size_t)k * TT + u.pm * 256 + tid, __ATOMIC_RELAXED, __HIP_MEMORY_SCOPE_AGENT);
            rf[tid] = rsqrtf(s4 * (1.f / 1024.f) + RMS_EPS); }
        asm volatile("s_waitcnt vmcnt(0) lgkmcnt(0)" ::: "memory"); __builtin_amdgcn_s_barrier(); asm volatile("" ::: "memory");
#pragma unroll
        for (int bj = 0; bj < 2; ++bj) { const f32x4 g0 = *(const f32x4*)(gfin + colb + bj * 128), g1 = *(const f32x4*)(gfin + colb + bj * 128 + 4);
#pragma unroll
            for (int ai = 0; ai < 2; ++ai)
#pragma unroll
                for (int m = 0; m < 4; ++m) { const int rl = ai * 128 + wr * 64 + m * 16 + fr; const float r = rf[rl]; float* op = out + (size_t)(u.pm * 256 + rl) * DM + colb + bj * 128;
                    *(f32x4*)op = acc[ai][bj][m][0] * r * g0; *(f32x4*)(op + 4) = acc[ai][bj][m][1] * r * g1; } }
        asm volatile("s_waitcnt lgkmcnt(0)" ::: "memory"); __builtin_amdgcn_s_barrier(); asm volatile("" ::: "memory");
    }
};
struct EpiStoreBf16 { bf16_t* O; int ldc;
    DI void operator()(const AccT& acc, const Unit& u, int wr, int wc, int fr, int fq) const {
        const int row0 = u.pm * 256 + wr * 64 + fr;
#pragma unroll
        for (int ai = 0; ai < 2; ++ai)
#pragma unroll
            for (int m = 0; m < 4; ++m) { const int row = row0 + ai * 128 + m * 16;
#pragma unroll
                for (int bj = 0; bj < 2; ++bj) *(u32x4*)(O + (size_t)row * ldc + u.pn * 256 + bj * 128 + wc * 32 + 8 * fq) = pack8(acc[ai][bj][m][0], acc[ai][bj][m][1]); }
    }
};
struct EpiWin { const float* SS; const float* cs; const float* sn; bf16_t *Q, *KC, *VC, *KS, *VS, *KW, *VW; float* gates; bf16_t* Aext;
    DI void operator()(const AccT& acc, const Unit& u, int wr, int wc, int fr, int fq) const {
        float rs[2][4]; const int row0 = u.pm * 256 + wr * 64 + fr; load_rowscales(SS, row0, fq, rs);
        const int pn = u.pn; const bool ropet = (pn < 3 || (pn == 3 && wc < 2));
        f32x4 ivr[2]; ivr[0] = *(const f32x4*)(cs + 8 * fq); ivr[1] = *(const f32x4*)(cs + 8 * fq + 4);
#pragma unroll
        for (int aim = 0; aim < 4; ++aim) { const int ai = aim >> 1, mh = aim & 1;
            f32x4 pc[2][2], psn[2][2];
            if (ropet) {
#pragma unroll
                for (int mm = 0; mm < 2; ++mm) { const float tf = (float)((row0 + ai * 128 + (2 * mh + mm) * 16) & 8191);
#pragma unroll
                    for (int n = 0; n < 2; ++n)
#pragma unroll
                        for (int e = 0; e < 4; ++e) { const float rev = __builtin_amdgcn_fractf(tf * ivr[n][e]); pc[mm][n][e] = __builtin_amdgcn_cosf(rev); psn[mm][n][e] = __builtin_amdgcn_sinf(rev); } } }
#pragma unroll
            for (int mm = 0; mm < 2; ++mm) { const int m = 2 * mh + mm; const int row = row0 + ai * 128 + m * 16; const float r = rs[ai][m]; const int b = row >> 13, t = row & 8191;
                if (ropet) {
                    const int d0 = 8 * fq; f32x4 y1[2], y2[2];
#pragma unroll
                    for (int n = 0; n < 2; ++n) { const f32x4 c = pc[mm][n], s = psn[mm][n];
                        const f32x4 x1 = acc[ai][0][m][n] * r, x2 = acc[ai][1][m][n] * r; y1[n] = x1 * c - x2 * s; y2[n] = x1 * s + x2 * c; }
                    bf16_t* ptr;
                    if (pn < 2) { const int head = 4 * pn + wc; ptr = Q + ((size_t)(b * 8 + head) * SEQ + t) * 64;
#pragma unroll
                        for (int n = 0; n < 2; ++n) { y1[n] = y1[n] * QC2; y2[n] = y2[n] * QC2; } }
                    else if (pn == 2) { ptr = (wc < 2 ? KC : KS) + ((size_t)(b * 2 + (wc & 1)) * SEQ + t) * 64; }
                    else { ptr = KW + ((size_t)(b * 2 + wc) * SEQ + t) * 64; }
                    *(u32x4*)(ptr + d0) = pack8(y1[0], y1[1]); *(u32x4*)(ptr + 32 + d0) = pack8(y2[0], y2[1]);
                } else if (pn == 3) {
#pragma unroll
                    for (int bj = 0; bj < 2; ++bj) *(u32x4*)(VC + ((size_t)(b * 2 + bj) * SEQ + t) * 64 + (wc - 2) * 32 + 8 * fq) = pack8(acc[ai][bj][m][0] * r, acc[ai][bj][m][1] * r);
                } else if (pn == 4) {
#pragma unroll
                    for (int bj = 0; bj < 2; ++bj) *(u32x4*)((bj ? VW : VS) + ((size_t)(b * 2 + (wc >> 1)) * SEQ + t) * 64 + (wc & 1) * 32 + 8 * fq) = pack8(acc[ai][bj][m][0] * r, acc[ai][bj][m][1] * r);
                } else if (pn < 7) {
#pragma unroll
                    for (int bj = 0; bj < 2; ++bj) { const int col = (pn - 5) * 256 + bj * 128 + wc * 32 + 8 * fq, gg = col >> 4, i0 = col & 15;
                        *(u32x4*)(Aext + ((size_t)(gg * 512 + b * 128 + (t >> 6))) * 1152 + 128 + (t & 63) * 16 + i0) = pack8(acc[ai][bj][m][0] * r, acc[ai][bj][m][1] * r); }
                } else {
                    if (wc == 0 && fq < 3) {
#pragma unroll
                        for (int n = 0; n < 2; ++n)
#pragma unroll
                            for (int e = 0; e < 4; ++e) gates[(size_t)row * 24 + 8 * fq + 4 * n + e] = sigmoidf_(acc[ai][0][m][n][e] * r); }
                }
            }
        }
    }
};
struct EpiCmp1 { bf16_t* Hc; const float* bias;
    DI void operator()(const AccT& acc, const Unit& u, int wr, int wc, int fr, int fq) const {
        const int row0 = u.pm * 256 + wr * 64 + fr;
#pragma unroll
        for (int bj = 0; bj < 2; ++bj) { const int col = bj * 128 + wc * 32 + 8 * fq; const f32x4 bb0 = *(const f32x4*)(bias + col), bb1 = *(const f32x4*)(bias + col + 4);
#pragma unroll
            for (int ai = 0; ai < 2; ++ai)
#pragma unroll
                for (int m = 0; m < 4; ++m) { const int row = row0 + ai * 128 + m * 16; f32x4 o0, o1;
#pragma unroll
                    for (int e = 0; e < 4; ++e) { o0[e] = gelu_tanh(acc[ai][bj][m][0][e] + bb0[e]); o1[e] = gelu_tanh(acc[ai][bj][m][1][e] + bb1[e]); }
                    *(u32x4*)(Hc + (size_t)row * 256 + col) = pack8(o0, o1); } }
    }
};
struct EpiSloc { float* Sloc;
    DI void operator()(const AccT& acc, const Unit& u, int wr, int wc, int fr, int fq) const {
        const int row0 = u.g * 512 + u.pm * 256 + wr * 64 + fr;
#pragma unroll
        for (int ai = 0; ai < 2; ++ai)
#pragma unroll
            for (int m = 0; m < 4; ++m) { const int row = row0 + ai * 128 + m * 16; float* p = Sloc + (size_t)row * 128 + wc * 32 + 8 * fq;
                *(f32x4*)p = acc[ai][0][m][0]; *(f32x4*)(p + 4) = acc[ai][0][m][1]; }
    }
};
struct EpiS5Y { bf16_t* Yp;
    DI void operator()(const AccT& acc, const Unit& u, int wr, int wc, int fr, int fq) const {
        const int row0 = u.pm * 256 + wr * 64 + fr;
#pragma unroll
        for (int ai = 0; ai < 2; ++ai)
#pragma unroll
            for (int m = 0; m < 4; ++m) { const int lr = row0 + ai * 128 + m * 16, b = lr >> 7, ch = lr & 127;
#pragma unroll
                for (int bj = 0; bj < 2; ++bj) { const int cn = u.pn * 256 + bj * 128 + wc * 32 + 8 * fq, t = cn >> 4, o0 = cn & 15; f32x4 y0, y1;
#pragma unroll
                    for (int e = 0; e < 4; ++e) { y0[e] = gelu_tanh(acc[ai][bj][m][0][e]); y1[e] = gelu_tanh(acc[ai][bj][m][1][e]); }
                    *(u32x4*)(Yp + ((size_t)(b * SEQ + ch * 64 + t)) * 512 + u.g * 16 + o0) = pack8(y0, y1); } }
    }
};
struct EpiGLU { const bf16_t* Yp; const float* bglu; bf16_t* Oc;
    DI void operator()(const AccT& acc, const Unit& u, int wr, int wc, int fr, int fq) const {
        const int row0 = u.pm * 256 + wr * 64 + fr;
#pragma unroll
        for (int bj = 0; bj < 2; ++bj) { const int col = u.pn * 256 + bj * 128 + wc * 32 + 8 * fq; const f32x4 bb0 = *(const f32x4*)(bglu + col), bb1 = *(const f32x4*)(bglu + col + 4);
#pragma unroll
            for (int ai = 0; ai < 2; ++ai)
#pragma unroll
                for (int m = 0; m < 4; ++m) { const int row = row0 + ai * 128 + m * 16; const u32x4 yv = *(const u32x4*)(Yp + (size_t)row * 512 + col); f32x4 o0, o1;
#pragma unroll
                    for (int e = 0; e < 4; ++e) { const unsigned w0 = yv[e >> 1], w1 = yv[2 + (e >> 1)];
                        const float y0 = (e & 1) ? __uint_as_float(w0 & 0xffff0000u) : __uint_as_float(w0 << 16), y1 = (e & 1) ? __uint_as_float(w1 & 0xffff0000u) : __uint_as_float(w1 << 16);
                        o0[e] = y0 * sigmoidf_(acc[ai][bj][m][0][e] + bb0[e]); o1[e] = y1 * sigmoidf_(acc[ai][bj][m][1][e] + bb1[e]); }
                    *(u32x4*)(Oc + (size_t)row * DM + 512 + col) = pack8(o0, o1); } }
    }
};

struct KP { const float* in[33]; float* out; unsigned char* ws; };

DI int win_src_col(int n) {
    const int pn = n >> 8, bj = (n >> 7) & 1, wc = (n >> 5) & 3, d = n & 31;
    if (pn < 2) return (4 * pn + wc) * 64 + 32 * bj + d;
    if (pn == 2) return (wc < 2 ? 512 + wc * 64 : 768 + (wc - 2) * 64) + 32 * bj + d;
    if (pn == 3) return (wc < 2) ? 1024 + wc * 64 + 32 * bj + d : 640 + bj * 64 + (wc - 2) * 32 + d;
    if (pn == 4) return (bj ? 1152 : 896) + wc * 32 + d;
    if (pn < 7) return 1304 + (pn - 5) * 256 + (n & 255);
    return ((n & 255) < 24) ? 1280 + (n & 255) : -1;
}
DI void transpose_item(int kind, const float* W, const float* W3, int Nsrc, int K, int Np, const float* sc, bf16_t* Bt, LAS float* scr, int item, int lane) {
    const int nblk = Np / 32, kb = item / nblk, nb = item % nblk, k0 = 64 * kb, n0 = 32 * nb;
    const int n = n0 + (lane & 31); const float* src = W; int col = n;
    if (kind == 1) { const int j = n & 255; col = 128 * (n >> 8) + (j & 127); src = (j < 128) ? W : W3; }
    else if (kind == 2) col = win_src_col(n);
    const bool valid = col >= 0; const float* p = src + (valid ? col : 0) + (size_t)(k0 + (lane >> 5)) * Nsrc;
    float v[32];
#pragma unroll
    for (int i = 0; i < 32; ++i) v[i] = p[(size_t)(2 * i) * Nsrc];
#pragma unroll
    for (int i = 0; i < 32; ++i) scr[(2 * i + (lane >> 5)) * 33 + (lane & 31)] = valid ? v[i] : 0.f;
    asm volatile("s_waitcnt lgkmcnt(0)" ::: "memory");
    const int c = lane & 7;
    f32x4 sc0 = (f32x4){1.f, 1.f, 1.f, 1.f}, sc1 = sc0;
    if (sc) { sc0 = *(const f32x4*)(sc + k0 + 8 * c); sc1 = *(const f32x4*)(sc + k0 + 8 * c + 4); }
#pragma unroll
    for (int j = 0; j < 4; ++j) { const int nn = (lane >> 3) + 8 * j; const LAS float* s = scr + (8 * c) * 33 + nn;
        u32x4 o; o.x = cvtpk(s[0 * 33] * sc0[0], s[1 * 33] * sc0[1]); o.y = cvtpk(s[2 * 33] * sc0[2], s[3 * 33] * sc0[3]); o.z = cvtpk(s[4 * 33] * sc1[0], s[5 * 33] * sc1[1]); o.w = cvtpk(s[6 * 33] * sc1[2], s[7 * 33] * sc1[3]);
        *(u32x4*)(Bt + (size_t)(n0 + nn) * K + k0 + 8 * c) = o; }
    asm volatile("s_waitcnt lgkmcnt(0)" ::: "memory");
}
DI float wave_sum(float v) {
#pragma unroll
    for (int o = 1; o < 64; o <<= 1) v += __shfl_xor(v, o);
    return v;
}
DI void sincos_d(double x, double& s, double& c) {
    const double TWO_PI_HI = 6.283185307179586232, TWO_PI_LO = 2.4492935982947064e-16, INV2PI = 0.15915494309189533577;
    const double k = __builtin_rint(x * INV2PI); double r = (x - k * TWO_PI_HI) - k * TWO_PI_LO;
    const double q = __builtin_rint(r * 0.63661977236758134308); const int qi = (int)q;
    const double y = (r - q * 1.5707963267948965580) - q * 6.1232339957367660e-17; const double y2 = y * y;
    double sp = 1.0 / 6227020800.0; sp = sp * y2 - 1.0 / 39916800.0; sp = sp * y2 + 1.0 / 362880.0; sp = sp * y2 - 1.0 / 5040.0; sp = sp * y2 + 1.0 / 120.0; sp = sp * y2 - 1.0 / 6.0; sp = sp * y2 + 1.0;
    double cp = -1.0 / 87178291200.0; cp = cp * y2 + 1.0 / 479001600.0; cp = cp * y2 - 1.0 / 3628800.0; cp = cp * y2 + 1.0 / 40320.0; cp = cp * y2 - 1.0 / 720.0; cp = cp * y2 + 1.0 / 24.0; cp = cp * y2 - 0.5; cp = cp * y2 + 1.0;
    const double sy = sp * y, cy = cp;
    switch (qi & 3) { case 0: s = sy; c = cy; break; case 1: s = cy; c = -sy; break; case 2: s = -sy; c = -cy; break; default: s = -cy; c = sy; break; }
}

constexpr int AT_KL = 0, AT_VL = 9216, AT_IMP = 18432, AT_SEL = AT_IMP + 32768, AT_BLIST = AT_SEL + 1024, AT_NL = AT_BLIST + 512;
constexpr int AT_OTP = AT_NL + 16;
DI int crow(int r, int hi) { return (r & 3) + 8 * (r >> 2) + 4 * hi; }
#define MFMA32(a, b, c) __builtin_amdgcn_mfma_f32_32x32x16_bf16((a), (b), (c), 0, 0, 0)
DI s16x4 tr_rd(LAS const unsigned char* p) { typedef short v4s __attribute__((ext_vector_type(4))); return __builtin_bit_cast(s16x4, __builtin_amdgcn_ds_read_tr16_b64_v4i16((LAS v4s*)p)); }
DI bf16x8 packp(const f32x16& x, int s) { u32x4 p; p.x = cvtpk(x[8 * s], x[8 * s + 1]); p.y = cvtpk(x[8 * s + 2], x[8 * s + 3]); p.z = cvtpk(x[8 * s + 4], x[8 * s + 5]); p.w = cvtpk(x[8 * s + 6], x[8 * s + 7]); return __builtin_bit_cast(bf16x8, p); }

struct AttnP { const bf16_t *Q, *KS, *VS, *KW, *VW, *KCc, *VCc; const float* gates; bf16_t* Oc; };

DI void qk_tile(LAS const unsigned char* Kl, const bf16x8 (&qr)[4], const f32x16& c0, int r32, int hi, f32x16& p0, f32x16& p1) {
    { const bf16x8 a0 = *(const LAS bf16x8*)(Kl + r32 * 144 + (8 * hi) * 2), a1 = *(const LAS bf16x8*)(Kl + (32 + r32) * 144 + (8 * hi) * 2);
      p0 = MFMA32(a0, qr[0], c0); p1 = MFMA32(a1, qr[0], c0); }
#pragma unroll
    for (int s = 1; s < 4; ++s) { const bf16x8 a0 = *(const LAS bf16x8*)(Kl + r32 * 144 + (16 * s + 8 * hi) * 2), a1 = *(const LAS bf16x8*)(Kl + (32 + r32) * 144 + (16 * s + 8 * hi) * 2);
        p0 = MFMA32(a0, qr[s], p0); p1 = MFMA32(a1, qr[s], p1); }
}
template <int MODE>
DI void attn_branch(LAS unsigned char* lds, const bf16_t* Kg, const bf16_t* Vg, int nblk, int jfirst, int cur, const bf16x8 (&qr)[4], int t, int tl, float& m_run, float& l_run, f32x16 (&o)[2]) {
    int tid = threadIdx.x; asm volatile("" : "+v"(tid));
    const int lane = tid & 63, r32 = lane & 31, hi = lane >> 5;
    LAS unsigned char* Kl = lds + AT_KL; LAS unsigned char* Vl = lds + AT_VL;
    LAS const int* blist = (LAS const int*)(lds + AT_BLIST); LAS const unsigned short* sel16 = (LAS const unsigned short*)(lds + AT_SEL);
    const int cmax = (t >= 31) ? ((t - 31) >> 4) : -1;
    float mref = 0.f, l = 0.f; bool first = true; f32x16 negm;
#pragma unroll
    for (int i = 0; i < 16; ++i) { o[0][i] = 0.f; o[1][i] = 0.f; negm[i] = 0.f; }
    const int ldoff = tid * 8, stoff = (tid >> 3) * 144 + (tid & 7) * 16;
    const int q4 = (lane & 15) >> 2, pp = lane & 3, blk = (lane >> 4) & 1;
    int j = (MODE == 1) ? blist[0] : jfirst;
    u32x4 kreg = *(const u32x4*)(Kg + (size_t)j * 4096 + ldoff), vreg = *(const u32x4*)(Vg + (size_t)j * 4096 + ldoff);
    for (int it = 0; it < nblk; ++it) {
        __syncthreads();
        *(LAS u32x4*)(Kl + stoff) = kreg; *(LAS u32x4*)(Vl + stoff) = vreg;
        __syncthreads();
        const int jc = j;
        if (it + 1 < nblk) { j = (MODE == 1) ? blist[it + 1] : jfirst + it + 1; kreg = *(const u32x4*)(Kg + (size_t)j * 4096 + ldoff); vreg = *(const u32x4*)(Vg + (size_t)j * 4096 + ldoff); }
        bool sel = true;
        if (MODE == 1) { const unsigned w = sel16[tl * 8 + (jc >> 4)]; sel = ((w >> (jc & 15)) & 1u) != 0u; if (!__any(sel)) continue; }
        f32x16 p0, p1; qk_tile(Kl, qr, negm, r32, hi, p0, p1);
        if (MODE == 0) {
#pragma unroll
            for (int i = 0; i < 16; ++i) { const int c = 64 * jc + crow(i, hi); if (c > cmax) p0[i] = -1e30f; if (c + 32 > cmax) p1[i] = -1e30f; }
        } else {
            if (jc == cur) {
#pragma unroll
                for (int i = 0; i < 16; ++i) { const int kk = crow(i, hi); if (kk > tl) p0[i] = -1e30f; if (kk + 32 > tl) p1[i] = -1e30f; }
            } else if (MODE == 2 && jc == cur - 8) {
#pragma unroll
                for (int i = 0; i < 16; ++i) { const int kk = crow(i, hi); if (kk <= tl) p0[i] = -1e30f; if (kk + 32 <= tl) p1[i] = -1e30f; }
            }
        }
        float mx = fmaxf(fmaxf(p0[0], p0[1]), p1[0]), my = fmaxf(fmaxf(p0[2], p0[3]), p1[1]);
        mx = fmaxf(fmaxf(mx, p1[2]), p1[3]);
#pragma unroll
        for (int i = 4; i < 16; i += 4) { mx = fmaxf(fmaxf(mx, p0[i]), p0[i + 1]); my = fmaxf(fmaxf(my, p0[i + 2]), p0[i + 3]); mx = fmaxf(fmaxf(mx, p1[i]), p1[i + 1]); my = fmaxf(fmaxf(my, p1[i + 2]), p1[i + 3]); }
        float rm = fmaxf(mx, my); rm = fmaxf(rm, __shfl_xor(rm, 32));
        if (first || __any(rm > 8.f)) {
            const float dl = first ? fmaxf(rm, -100.f) : fmaxf(rm, 0.f);
            mref += dl;
#pragma unroll
            for (int i = 0; i < 16; ++i) { p0[i] -= dl; p1[i] -= dl; negm[i] = -mref; }
            const float f = __builtin_amdgcn_exp2f(-dl); l *= f;
#pragma unroll
            for (int i = 0; i < 16; ++i) { o[0][i] *= f; o[1][i] *= f; }
            first = false;
        }
        float ps = 0.f, pt = 0.f;
#pragma unroll
        for (int i = 0; i < 16; ++i) { p0[i] = __builtin_amdgcn_exp2f(p0[i]); p1[i] = __builtin_amdgcn_exp2f(p1[i]); ps += p0[i]; pt += p1[i]; }
        l += sel ? (ps + pt) : 0.f;
        u32x4 pw[4];
        pw[0] = __builtin_bit_cast(u32x4, packp(p0, 0)); pw[1] = __builtin_bit_cast(u32x4, packp(p0, 1)); pw[2] = __builtin_bit_cast(u32x4, packp(p1, 0)); pw[3] = __builtin_bit_cast(u32x4, packp(p1, 1));
        if (MODE == 1) { const unsigned sm = sel ? 0xffffffffu : 0u;
#pragma unroll
            for (int k = 0; k < 4; ++k) { pw[k].x &= sm; pw[k].y &= sm; pw[k].z &= sm; pw[k].w &= sm; } }
#pragma unroll
        for (int dblk = 0; dblk < 2; ++dblk)
#pragma unroll
            for (int ks = 0; ks < 4; ++ks) { const int rb = 32 * (ks >> 1) + 16 * (ks & 1) + 4 * hi + q4;
                LAS const unsigned char* vp = Vl + rb * 144 + (32 * dblk + 16 * blk) * 2 + 8 * pp;
                const s16x4 lo = tr_rd(vp), hh = tr_rd(vp + 8 * 144);
                const bf16x8 vf = __builtin_shufflevector(lo, hh, 0, 1, 2, 3, 4, 5, 6, 7);
                o[dblk] = MFMA32(vf, __builtin_bit_cast(bf16x8, pw[ks]), o[dblk]); }
    }
    m_run = mref; l_run = l;
}

template <int MODE>
DI void attn_branch_fast(LAS unsigned char* lds, const bf16_t* Kg, const bf16_t* Vg, int nblk, int jfirst, int cur, const bf16x8 (&qr)[4], int t, int tl, float& m_run, float& l_run, f32x16 (&o)[2]) {
    int tid = threadIdx.x; asm volatile("" : "+v"(tid));
    const int lane = tid & 63, r32 = lane & 31, hi = lane >> 5;
    LAS unsigned char* Kl = lds + AT_KL; LAS unsigned char* Vl = lds + AT_VL;
    LAS const int* blist = (LAS const int*)(lds + AT_BLIST); LAS const unsigned short* sel16 = (LAS const unsigned short*)(lds + AT_SEL);
    const int cmax = (t >= 31) ? ((t - 31) >> 4) : -1;
    f32x16 lacc; bf16x8 ones;
#pragma unroll
    for (int i = 0; i < 8; ++i) ones[i] = (short)0x3F80;
    f32x16 negm;
#pragma unroll
    for (int i = 0; i < 16; ++i) { o[0][i] = 0.f; o[1][i] = 0.f; negm[i] = 0.f; lacc[i] = 0.f; }
    const int ldoff = tid * 8, stoff = (tid >> 3) * 144 + (tid & 7) * 16;
    const int q4 = (lane & 15) >> 2, pp = lane & 3, blk = (lane >> 4) & 1;
    int j = (MODE == 1) ? blist[0] : jfirst;
    u32x4 kreg = *(const u32x4*)(Kg + (size_t)j * 4096 + ldoff), vreg = *(const u32x4*)(Vg + (size_t)j * 4096 + ldoff);
    for (int it = 0; it < nblk; ++it) {
        __syncthreads();
        *(LAS u32x4*)(Kl + stoff) = kreg; *(LAS u32x4*)(Vl + stoff) = vreg;
        __syncthreads();
        const int jc = j;
        if (it + 1 < nblk) { j = (MODE == 1) ? blist[it + 1] : jfirst + it + 1; kreg = *(const u32x4*)(Kg + (size_t)j * 4096 + ldoff); vreg = *(const u32x4*)(Vg + (size_t)j * 4096 + ldoff); }
        bool sel = true;
        if (MODE == 1) { const unsigned w = sel16[tl * 8 + (jc >> 4)]; sel = ((w >> (jc & 15)) & 1u) != 0u; if (!__any(sel)) continue; }
        bf16x8 kf[8];
#pragma unroll
        for (int s = 0; s < 4; ++s) { kf[2 * s] = *(const LAS bf16x8*)(Kl + r32 * 144 + (16 * s + 8 * hi) * 2); kf[2 * s + 1] = *(const LAS bf16x8*)(Kl + (32 + r32) * 144 + (16 * s + 8 * hi) * 2); }
        s16x4 vlo[8], vhi[8];
#pragma unroll
        for (int dblk = 0; dblk < 2; ++dblk)
#pragma unroll
            for (int ks = 0; ks < 4; ++ks) { const int rb = 32 * (ks >> 1) + 16 * (ks & 1) + 4 * hi + q4;
                LAS const unsigned char* vp = Vl + rb * 144 + (32 * dblk + 16 * blk) * 2 + 8 * pp;
                vlo[dblk * 4 + ks] = tr_rd(vp); vhi[dblk * 4 + ks] = tr_rd(vp + 8 * 144); }
        __builtin_amdgcn_sched_barrier(0);
        f32x16 p0 = MFMA32(kf[0], qr[0], negm), p1 = MFMA32(kf[1], qr[0], negm);
#pragma unroll
        for (int s = 1; s < 4; ++s) { p0 = MFMA32(kf[2 * s], qr[s], p0); p1 = MFMA32(kf[2 * s + 1], qr[s], p1); }
        if (MODE == 0) {
#pragma unroll
            for (int i = 0; i < 16; ++i) { const int c = 64 * jc + crow(i, hi); if (c > cmax) p0[i] = -1e30f; if (c + 32 > cmax) p1[i] = -1e30f; }
        } else {
            if (jc == cur) {
#pragma unroll
                for (int i = 0; i < 16; ++i) { const int kk = crow(i, hi); if (kk > tl) p0[i] = -1e30f; if (kk + 32 > tl) p1[i] = -1e30f; }
            } else if (MODE == 2 && jc == cur - 8) {
#pragma unroll
                for (int i = 0; i < 16; ++i) { const int kk = crow(i, hi); if (kk <= tl) p0[i] = -1e30f; if (kk + 32 <= tl) p1[i] = -1e30f; }
            }
        }
#pragma unroll
        for (int i = 0; i < 16; ++i) { p0[i] = __builtin_amdgcn_exp2f(p0[i]); p1[i] = __builtin_amdgcn_exp2f(p1[i]); }
        u32x4 pw[4];
        pw[0] = __builtin_bit_cast(u32x4, packp(p0, 0)); pw[1] = __builtin_bit_cast(u32x4, packp(p0, 1)); pw[2] = __builtin_bit_cast(u32x4, packp(p1, 0)); pw[3] = __builtin_bit_cast(u32x4, packp(p1, 1));
        if (MODE == 1) { const unsigned sm = sel ? 0xffffffffu : 0u;
#pragma unroll
            for (int k = 0; k < 4; ++k) { pw[k].x &= sm; pw[k].y &= sm; pw[k].z &= sm; pw[k].w &= sm; } }
#pragma unroll
        for (int ks = 0; ks < 4; ++ks)
#pragma unroll
            for (int dblk = 0; dblk < 2; ++dblk) { const bf16x8 vf = __builtin_shufflevector(vlo[dblk * 4 + ks], vhi[dblk * 4 + ks], 0, 1, 2, 3, 4, 5, 6, 7);
                o[dblk] = MFMA32(vf, __builtin_bit_cast(bf16x8, pw[ks]), o[dblk]); }
#pragma unroll
        for (int ks = 0; ks < 4; ++ks) lacc = MFMA32(ones, __builtin_bit_cast(bf16x8, pw[ks]), lacc);
    }
    const float l = lacc[0]; const bool bad = !(l < 1e15f);
    m_run = bad ? 1.f : 0.f; l_run = 0.5f * l;
}

DI void attn_unit(LAS unsigned char* lds, const AttnP& P, int b, int g, int qb) {
    int tid = threadIdx.x; asm volatile("" : "+v"(tid));
    const int lane = tid & 63, w = tid >> 6, r32 = lane & 31, hi = lane >> 5;
    const int tt = r32 & 7, h = r32 >> 3, tl = 8 * w + tt, t0 = qb * 64, t = t0 + tl, cur = qb;
    LAS float* imp = (LAS float*)(lds + AT_IMP); LAS unsigned short* sel16 = (LAS unsigned short*)(lds + AT_SEL); LAS int* blist = (LAS int*)(lds + AT_BLIST); LAS int* nl = (LAS int*)(lds + AT_NL);
    const size_t bg = (size_t)(b * 2 + g);
    const bf16_t* qp = P.Q + ((size_t)(b * 8 + 4 * g + h) * SEQ + t) * 64 + 8 * hi;
    bf16x8 qr[4];
#pragma unroll
    for (int s = 0; s < 4; ++s) qr[s] = *(const bf16x8*)(qp + 16 * s);
#define AT_GATE(k_) (P.gates[(size_t)(b * SEQ + t) * 24 + (4 * g + h) * 3 + (k_)])
    LAS unsigned* otp = (LAS unsigned*)(lds + AT_OTP) + tid; f32x16 o[2]; float m_run, l_run;
    __syncthreads();
    for (int i = tid; i < 64 * 128; i += 512) imp[i] = 0.f;
    const bf16_t* Kc = P.KCc + bg * 512 * 64; const bf16_t* Vc = P.VCc + bg * 512 * 64;
    const int ncb = (((t0 + 63 - 31) >> 4) >> 6) + 1;
    attn_branch_fast<0>(lds, Kc, Vc, ncb, 0, cur, qr, t, tl, m_run, l_run, o);
    if (__syncthreads_or(m_run != 0.f)) attn_branch<0>(lds, Kc, Vc, ncb, 0, cur, qr, t, tl, m_run, l_run, o);
    {
        const float lt = l_run + __shfl_xor(l_run, 32); const float inv = lt > 0.f ? 1.f / lt : 0.f; const float sc = AT_GATE(0) * inv;
#pragma unroll
        for (int i = 0; i < 8; ++i) { otp[i * 512] = cvtpk(o[0][2 * i] * sc, o[0][2 * i + 1] * sc); otp[(8 + i) * 512] = cvtpk(o[1][2 * i] * sc, o[1][2 * i + 1] * sc); }
        const float m_sub = m_run; f32x16 zc;
#pragma unroll
        for (int i = 0; i < 16; ++i) zc[i] = 0.f;
        const int cmax = (t >= 31) ? ((t - 31) >> 4) : -1;
        bf16x8 ovf[4];
#pragma unroll
        for (int ks = 0; ks < 4; ++ks)
#pragma unroll
            for (int jj = 0; jj < 8; ++jj) { const int key = 32 * (ks >> 1) + 16 * (ks & 1) + 8 * (jj >> 2) + 4 * hi + (jj & 3); ovf[ks][jj] = (4 * r32 - 1 <= key && key <= 4 * r32 + 3) ? (short)0x3F80 : (short)0; }
        LAS unsigned char* Kl = lds + AT_KL; const int ldoff = tid * 8, stoff = (tid >> 3) * 144 + (tid & 7) * 16;
        u32x4 kreg = *(const u32x4*)(Kc + ldoff);
        for (int it = 0; it < ncb; ++it) {
            __syncthreads();
            *(LAS u32x4*)(Kl + stoff) = kreg;
            __syncthreads();
            if (it + 1 < ncb) kreg = *(const u32x4*)(Kc + (size_t)(it + 1) * 4096 + ldoff);
            f32x16 p0, p1; qk_tile(Kl, qr, zc, r32, hi, p0, p1);
#pragma unroll
            for (int i = 0; i < 16; ++i) { const int c = 64 * it + crow(i, hi);
                p0[i] = (c <= cmax) ? __builtin_amdgcn_exp2f(p0[i] - m_sub) * inv : 0.f; p1[i] = (c + 32 <= cmax) ? __builtin_amdgcn_exp2f(p1[i] - m_sub) * inv : 0.f; }
            bf16x8 pf[4]; pf[0] = packp(p0, 0); pf[1] = packp(p0, 1); pf[2] = packp(p1, 0); pf[3] = packp(p1, 1);
            f32x16 it_;
#pragma unroll
            for (int i = 0; i < 16; ++i) it_[i] = 0.f;
#pragma unroll
            for (int ks = 0; ks < 4; ++ks) it_ = MFMA32(ovf[ks], pf[ks], it_);
#pragma unroll
            for (int i = 0; i < 9; ++i) { float v = it_[i]; v += __shfl_xor(v, 8); v += __shfl_xor(v, 16);
                const int srel = crow(i, hi), s = 16 * it + srel;
                if (h == 0 && srel <= 16 && s < 128) imp[tl * 128 + s] += v; }
        }
    }
    __syncthreads();
    {
        const int tt2 = tid >> 3, part = tid & 7, s0 = 16 * part; unsigned bits = 0;
        if (cur < 16) { for (int k = 0; k < 16; ++k) if (s0 + k <= cur) bits |= 1u << k; }
        else {
            unsigned u[16]; unsigned cm = 0u;
#pragma unroll
            for (int k = 0; k < 16; ++k) { const int s = s0 + k; const bool cand = (s >= 1 && s <= cur - 2); u[k] = cand ? __float_as_uint(imp[tt2 * 128 + s]) : 0u; cm |= cand ? (1u << k) : 0u; }
            unsigned T = 0u;
            for (int bit = 30; bit >= 0; --bit) { const unsigned cd = T | (1u << bit); int c = 0;
#pragma unroll
                for (int k = 0; k < 16; ++k) c += (u[k] >= cd) ? 1 : 0;
                c += __shfl_xor(c, 1); c += __shfl_xor(c, 2); c += __shfl_xor(c, 4);
                if (c >= 13) T = cd; }
            unsigned gtm = 0u, eqm = 0u;
#pragma unroll
            for (int k = 0; k < 16; ++k) { gtm |= (u[k] > T) ? (1u << k) : 0u; eqm |= (u[k] == T) ? (1u << k) : 0u; }
            eqm &= cm; gtm &= cm;
            int cgt = __popc(gtm); cgt += __shfl_xor(cgt, 1); cgt += __shfl_xor(cgt, 2); cgt += __shfl_xor(cgt, 4);
            const int ceq = __popc(eqm); int pre = 0;
#pragma unroll
            for (int q = 0; q < 8; ++q) { const int cq = __shfl(ceq, (lane & ~7) | q); pre += (q < part) ? cq : 0; }
            int quota = 13 - cgt - pre; unsigned selq = 0u;
#pragma unroll
            for (int k = 0; k < 16; ++k) if ((eqm >> k) & 1u) { if (quota > 0) { selq |= 1u << k; --quota; } }
            bits = gtm | selq;
#pragma unroll
            for (int k = 0; k < 16; ++k) { const int s = s0 + k; if (s == 0 || s == cur || s == cur - 1) bits |= 1u << k; }
        }
        sel16[tt2 * 8 + part] = (unsigned short)bits;
    }
    __syncthreads();
    if (w == 0) {
        int base = 0;
        for (int half = 0; half < 2; ++half) { const int s = 64 * half + lane; unsigned any = 0;
            for (int q = 0; q < 64; ++q) any |= sel16[q * 8 + (s >> 4)];
            const bool need = ((any >> (s & 15)) & 1u) && s <= cur;
            const unsigned long long bm = __ballot(need);
            if (need) blist[base + __popcll(bm & ((1ull << lane) - 1ull))] = s;
            base += __popcll(bm); }
        if (lane == 0) nl[0] = base;
    }
    __syncthreads();
    {
        const int nsl = nl[0];
        attn_branch_fast<1>(lds, P.KS + bg * SEQ * 64, P.VS + bg * SEQ * 64, nsl, 0, cur, qr, t, tl, m_run, l_run, o);
    if (__syncthreads_or(m_run != 0.f)) attn_branch<1>(lds, P.KS + bg * SEQ * 64, P.VS + bg * SEQ * 64, nsl, 0, cur, qr, t, tl, m_run, l_run, o);
        const float lt = l_run + __shfl_xor(l_run, 32); const float sc = AT_GATE(1) * (lt > 0.f ? 1.f / lt : 0.f);
#pragma unroll
        for (int i = 0; i < 8; ++i) { const unsigned a_ = otp[i * 512], b_ = otp[(8 + i) * 512]; otp[i * 512] = cvtpk(__uint_as_float(a_ << 16) + o[0][2 * i] * sc, __uint_as_float(a_ & 0xffff0000u) + o[0][2 * i + 1] * sc);
            otp[(8 + i) * 512] = cvtpk(__uint_as_float(b_ << 16) + o[1][2 * i] * sc, __uint_as_float(b_ & 0xffff0000u) + o[1][2 * i + 1] * sc); }
    }
    {
        const int jf = cur >= 8 ? cur - 8 : 0;
        attn_branch_fast<2>(lds, P.KW + bg * SEQ * 64, P.VW + bg * SEQ * 64, cur - jf + 1, jf, cur, qr, t, tl, m_run, l_run, o);
    if (__syncthreads_or(m_run != 0.f)) attn_branch<2>(lds, P.KW + bg * SEQ * 64, P.VW + bg * SEQ * 64, cur - jf + 1, jf, cur, qr, t, tl, m_run, l_run, o);
        const float lt = l_run + __shfl_xor(l_run, 32); const float sc = AT_GATE(2) * (lt > 0.f ? 1.f / lt : 0.f);
#pragma unroll
        for (int i = 0; i < 8; ++i) { const unsigned a_ = otp[i * 512], b_ = otp[(8 + i) * 512]; otp[i * 512] = cvtpk(__uint_as_float(a_ << 16) + o[0][2 * i] * sc, __uint_as_float(a_ & 0xffff0000u) + o[0][2 * i + 1] * sc);
            otp[(8 + i) * 512] = cvtpk(__uint_as_float(b_ << 16) + o[1][2 * i] * sc, __uint_as_float(b_ & 0xffff0000u) + o[1][2 * i + 1] * sc); }
    }
    bf16_t* op = P.Oc + (size_t)(b * SEQ + t) * DM + (4 * g + h) * 64 + 4 * hi;
#pragma unroll
    for (int dblk = 0; dblk < 2; ++dblk)
#pragma unroll
        for (int ig = 0; ig < 4; ++ig) { u32x2 v; v.x = otp[(8 * dblk + 2 * ig) * 512]; v.y = otp[(8 * dblk + 2 * ig + 1) * 512];
            *(u32x2*)(op + 32 * dblk + 8 * ig) = v; }
}


#define XB_TMO      128
#define XB_XCNT(j)  (256  + 64 * (j))
#define XB_XSUB(j)  (1280 + 64 * (j))
#define XB_XGEN(j)  (2304 + 64 * (j))
#define XB_TOP      3328
#define XB_TOPGEN   3392
#define XCD_BAR_WORDS 3456
#define XB_SPIN_CAP (1u << 22)
DI unsigned xb_ld(unsigned* p)              { return __hip_atomic_load(p, __ATOMIC_RELAXED, __HIP_MEMORY_SCOPE_AGENT); }
DI unsigned xb_add(unsigned* p, unsigned v) { return __hip_atomic_fetch_add(p, v, __ATOMIC_RELAXED, __HIP_MEMORY_SCOPE_AGENT); }
DI unsigned xb_xcc_id() { return (unsigned)__builtin_amdgcn_s_getreg((3 << 11) | 20) & 0xFu; }
#define XB_SPIN(cond, bar) do { unsigned _sp = 0; while (cond) { __builtin_amdgcn_s_sleep(1); \
    if ((++_sp & 255u) == 0u) { if (xb_ld(&(bar)[XB_TMO])) break; if (_sp > XB_SPIN_CAP) { atomicAdd(&(bar)[XB_TMO], 1u); break; } } } } while (0)
struct XcdBarrier { unsigned* bar; unsigned x; volatile LAS unsigned* st; };
DI XcdBarrier xcd_barrier_post(unsigned* bar, volatile LAS unsigned* st) {
    XcdBarrier b; b.bar = bar; b.x = xb_xcc_id(); b.st = st;
    if (threadIdx.x == 0) (void)xb_add(&bar[XB_XCNT(b.x)], 1u);
    return b;
}
DI void xcd_barrier_complete(unsigned* bar, unsigned x, unsigned& nloc, unsigned& nx) {
    const unsigned G = gridDim.x * gridDim.y * gridDim.z;
    unsigned sum, cnt, mine, sp = 0u;
    for (;;) {
        sum = 0u; cnt = 0u; mine = 0u;
#pragma unroll
        for (unsigned j = 0; j < 16; ++j) { const unsigned c = xb_ld(&bar[XB_XCNT(j)]); sum += c; cnt += (c > 0u) ? 1u : 0u; mine = (j == x) ? c : mine; }
        if (sum == G) break;
        __builtin_amdgcn_s_sleep(1);
        if ((++sp & 255u) == 0u) { if (xb_ld(&bar[XB_TMO])) break; if (sp > XB_SPIN_CAP) { atomicAdd(&bar[XB_TMO], 1u); break; } }
    }
    nloc = mine > 0u ? mine : 1u; nx = cnt > 0u ? cnt : 1u;
}
DI void xcd_barrier(const XcdBarrier& b) {
    asm volatile("s_waitcnt vmcnt(0)" ::: "memory");
    __syncthreads();
    if (threadIdx.x == 0) {
        unsigned* bar = b.bar;
        __builtin_amdgcn_s_waitcnt(0);
        unsigned nloc = b.st[0], nx = b.st[1];
        if (nloc == 0u) { xcd_barrier_complete(bar, b.x, nloc, nx); b.st[0] = nloc; b.st[1] = nx; }
        const unsigned old = xb_add(&bar[XB_XSUB(b.x)], 1u);
        const unsigned gen = old / nloc;
        if (old + 1u == (gen + 1u) * nloc) {
            __builtin_amdgcn_fence(__ATOMIC_RELEASE, "agent");
            asm volatile("s_waitcnt vmcnt(0)" ::: "memory");
            const unsigned og = xb_add(&bar[XB_TOP], 1u);
            const unsigned tg = og / nx;
            if (og + 1u == (tg + 1u) * nx) xb_add(&bar[XB_TOPGEN], 1u);
            else XB_SPIN(xb_ld(&bar[XB_TOPGEN]) == tg, bar);
            __builtin_amdgcn_fence(__ATOMIC_ACQUIRE, "agent");
            xb_add(&bar[XB_XGEN(b.x)], 1u);
            asm volatile("s_waitcnt vmcnt(0)" ::: "memory");
        } else {
            XB_SPIN(xb_ld(&bar[XB_XGEN(b.x)]) == gen, bar);
            __builtin_amdgcn_fence(__ATOMIC_ACQUIRE, "agent");
            asm volatile("s_waitcnt vmcnt(0)" ::: "memory");
        }
    }
    __syncthreads();
}

#ifndef REP_P0
#define REP_P0 1
#endif
#ifndef REP_P1
#define REP_P1 1
#endif
#ifndef REP_P2
#define REP_P2 1
#endif
#ifndef REP_P3
#define REP_P3 1
#endif
#ifndef REP_P4
#define REP_P4 1
#endif
#ifndef REP_P5
#define REP_P5 1
#endif
#ifndef REP_P6
#define REP_P6 1
#endif
#ifndef REP_P7
#define REP_P7 1
#endif
#ifndef REP_P8
#define REP_P8 1
#endif
#ifndef REP_P9
#define REP_P9 1
#endif
#ifndef REP_P10
#define REP_P10 1
#endif
#ifndef REP_P11
#define REP_P11 1
#endif
#ifndef REP_P12
#define REP_P12 1
#endif
constexpr int NTHR = 512;
constexpr int LDS_BYTES = 147456;

__global__ void __launch_bounds__(NTHR, 2) mega_fwd(KP kp) {
    extern __shared__ __attribute__((aligned(16))) unsigned char lds_raw[];
    LAS unsigned char* lds = (LAS unsigned char*)lds_raw;
    cg::grid_group grid = cg::this_grid();
    const int G = gridDim.x, bid = blockIdx.x, NGW = G * 8;
    volatile LAS unsigned* MISC = (volatile LAS unsigned*)(lds + 143360);
    if (threadIdx.x < 2) MISC[threadIdx.x] = 0u;
    __syncthreads();
    const XcdBarrier xbar = xcd_barrier_post((unsigned*)kp.ws, MISC);
    if (kp.out == nullptr) grid.sync();
    const float* x = kp.in[0]; const float* pin = kp.in[1];
    float* out = kp.out;
#define PH_BEGIN int tid = threadIdx.x; asm volatile("" : "+v"(tid)); const int lane = tid & 63, wave = __builtin_amdgcn_readfirstlane(tid >> 6), gw = bid * 8 + wave; unsigned char* ws = kp.ws; asm volatile("" : "+s"(ws)); (void)lane; (void)gw;
#define COS ((float*)(ws + WS_COS))
#define SIN ((float*)(ws + WS_SIN))
#define SS ((float*)(ws + WS_SS))
#define KR ((float*)(ws + WS_KR))
#define SS2 ((float*)(ws + WS_SS2))
#define A64 ((float*)(ws + WS_A64))
#define BIASP ((float*)(ws + WS_BIASP))
#define BIAS ((float*)(ws + WS_BIAS))
#define W13A ((bf16_t*)(ws + WS_W13A))
#define W2A ((bf16_t*)(ws + WS_W2A))
#define W13B ((bf16_t*)(ws + WS_W13B))
#define W2B ((bf16_t*)(ws + WS_W2B))
#define WIN ((bf16_t*)(ws + WS_WIN))
#define WOUT ((bf16_t*)(ws + WS_WOUT))
#define WG ((bf16_t*)(ws + WS_WG))
#define WPLE ((bf16_t*)(ws + WS_WPLE))
#define WGLU ((bf16_t*)(ws + WS_WGLU))
#define WK1 ((bf16_t*)(ws + WS_WK1))
#define WV1 ((bf16_t*)(ws + WS_WV1))
#define WK2 ((bf16_t*)(ws + WS_WK2))
#define WV2 ((bf16_t*)(ws + WS_WV2))
#define PB ((bf16_t*)(ws + WS_PB))
#define HB ((bf16_t*)(ws + WS_HB))
#define OC ((bf16_t*)(ws + WS_OC))
#define TTB ((bf16_t*)(ws + WS_TT))
#define PT ((bf16_t*)(ws + WS_PT))
#define EB ((bf16_t*)(ws + WS_E))
#define ACT ((bf16_t*)(ws + WS_ACT))
#define QB ((bf16_t*)(ws + WS_Q))
#define KC ((bf16_t*)(ws + WS_KC))
#define VC ((bf16_t*)(ws + WS_VC))
#define KS ((bf16_t*)(ws + WS_KS))
#define VS ((bf16_t*)(ws + WS_VS))
#define KW ((bf16_t*)(ws + WS_KW))
#define VW ((bf16_t*)(ws + WS_VW))
#define AEXT ((bf16_t*)(ws + WS_AEXT))
#define HC ((bf16_t*)(ws + WS_HC))
#define KCMP ((bf16_t*)(ws + WS_KCMP))
#define VCMP ((bf16_t*)(ws + WS_VCMP))
#define YP ((bf16_t*)(ws + WS_YP))
#define GATES ((float*)(ws + WS_GATES))
#define SLOC ((float*)(ws + WS_SLOC))

    for (int rep_ = 0; rep_ < REP_P0; ++rep_) {
        PH_BEGIN
        LAS float* scr = (LAS float*)(lds + wave * 16384);
        int itbase = 0;
#define TJOB(kind, W, W3, Nsrc, K, Np, sc, Bt) do { const int ni = ((K) / 64) * ((Np) / 32); int first = (gw - itbase) % NGW; if (first < 0) first += NGW; \
            for (int it = first; it < ni; it += NGW) transpose_item(kind, W, W3, Nsrc, K, Np, sc, Bt, scr, it, lane); itbase += ni; } while (0)
        TJOB(1, kp.in[3], kp.in[4], DFF, DM, 5632, kp.in[2], W13A);
        TJOB(0, kp.in[5], nullptr, DM, DFF, DM, nullptr, W2A);
        TJOB(1, kp.in[26], kp.in[27], DFF, DM, 5632, kp.in[25], W13B);
        TJOB(0, kp.in[28], nullptr, DM, DFF, DM, nullptr, W2B);
        TJOB(2, kp.in[7], nullptr, 1816, DM, 2048, kp.in[6], WIN);
        TJOB(0, kp.in[24], nullptr, DM, DM, DM, nullptr, WOUT);
        TJOB(0, kp.in[30], nullptr, DM, DM, DM, kp.in[29], WG);
        TJOB(0, kp.in[31], nullptr, DM, 256, DM, nullptr, WPLE);
        TJOB(0, kp.in[22], nullptr, 512, 512, 512, nullptr, WGLU);
        TJOB(0, kp.in[10], nullptr, 256, 2048, 256, nullptr, WK1);
        TJOB(0, kp.in[12], nullptr, 256, 2048, 256, nullptr, WV1);
        TJOB(0, kp.in[11], nullptr, 64, 256, 64, nullptr, WK2);
        TJOB(0, kp.in[13], nullptr, 64, 256, 64, nullptr, WV2);
#undef TJOB
        for (int m = gw; m < TT; m += NGW) { const f32x4* xr = (const f32x4*)(x + (size_t)m * DM) + lane; unsigned long long* o8 = (unsigned long long*)(HB + (size_t)m * DM) + lane; float s = 0.f;
#pragma unroll
            for (int j = 0; j < 4; ++j) { const f32x4 v = xr[64 * j]; s += (v[0] * v[0] + v[1] * v[1]) + (v[2] * v[2] + v[3] * v[3]); o8[64 * j] = (unsigned long long)cvtpk(v[0], v[1]) | ((unsigned long long)cvtpk(v[2], v[3]) << 32); }
            s = wave_sum(s);
            if (lane < 16) SS[(size_t)lane * TT + m] = (lane == 0) ? s : 0.f; }
        for (size_t i = (size_t)bid * NTHR + tid; i < (size_t)TT * 256 / 8; i += (size_t)G * NTHR) { const f32x4 a = *(const f32x4*)(pin + i * 8), b2 = *(const f32x4*)(pin + i * 8 + 4); *(u32x4*)(PB + i * 8) = pack8(a, b2); }
        for (int i = bid * NTHR + tid; i < 32; i += G * NTHR) { const float inv = (float)exp2(-(double)i / 32.0 * 13.287712379549449); COS[i] = (float)((double)inv * 0.15915494309189535); }
        for (int it = gw; it < 512; it += NGW) { const int kv = it >> 8, sl = it & 255; const float* pe = kp.in[8 + kv] + sl * 8; const float* w1 = kp.in[kv ? 12 : 10] + (size_t)(sl * 8) * 256; float a4[4] = {0.f, 0.f, 0.f, 0.f};
            float wv[8][4], pv[8];
#pragma unroll
            for (int k = 0; k < 8; ++k) { pv[k] = pe[k];
#pragma unroll
                for (int c = 0; c < 4; ++c) wv[k][c] = w1[k * 256 + lane + 64 * c]; }
#pragma unroll
            for (int k = 0; k < 8; ++k)
#pragma unroll
                for (int c = 0; c < 4; ++c) a4[c] += pv[k] * wv[k][c];
#pragma unroll
            for (int c = 0; c < 4; ++c) BIASP[(size_t)it * 256 + lane + 64 * c] = a4[c]; }
        {
            __syncthreads();
            LAS float* bre = (LAS float*)lds; LAS float* bim = bre + 1024; LAS float* cre = bim + 1024; LAS float* cim = cre + 1024;
            LAS float* W1r = cim + 1024; LAS float* W1i = W1r + 512; LAS float* W2r = W1i + 512; LAS float* W2i = W2r + 512;
            const float *a_re = kp.in[14], *a_im = kp.in[15], *log_dt = kp.in[16], *b_re = kp.in[17], *b_im = kp.in[18], *c_re = kp.in[19], *c_im = kp.in[20], *dsk = kp.in[21];
            for (int it = bid; it < 256; it += G) { const int g = it >> 3, j0 = (it & 7) * 8;
                __syncthreads();
                for (int idx = tid; idx < 1024; idx += NTHR) { bre[idx] = b_re[g * 1024 + idx]; bim[idx] = b_im[g * 1024 + idx]; cre[idx] = c_re[g * 1024 + idx]; cim[idx] = c_im[g * 1024 + idx]; }
                { const int jj = tid >> 6, n = tid & 63, j = j0 + jj; const double are = a_re[g * 64 + n], aim = a_im[g * 64 + n], dt = exp((double)log_dt[g]);
                    const double zr = are * dt, zi = aim * dt; double sn_, cs_; sincos_d(zi, sn_, cs_); const double ea = exp(zr), abr = ea * cs_, abi = ea * sn_;
                    const double nr = abr - 1.0, ni = abi, den = are * are + aim * aim, bcr = (nr * are + ni * aim) / den, bci = (ni * are - nr * aim) / den;
                    double sj, cj; sincos_d(zi * j, sj, cj); const double ej = exp(zr * j), er = ej * cj, ei = ej * sj;
                    W1r[tid] = (float)(er * bcr - ei * bci); W1i[tid] = (float)(er * bci + ei * bcr);
                    W2r[tid] = (float)(er * abr - ei * abi); W2i[tid] = (float)(er * abi + ei * abr);
                    if (j == 0) { double s6, c6; sincos_d(zi * 64.0, s6, c6); const double e6 = exp(zr * 64.0); A64[(g * 64 + n) * 2] = (float)(e6 * c6); A64[(g * 64 + n) * 2 + 1] = (float)(e6 * s6); } }
                __syncthreads();
#pragma unroll 1
                for (int q = 0; q < 4; ++q) { const int idx = tid + NTHR * q, jj = idx >> 8, o = (idx >> 4) & 15, i = idx & 15; float s = 0.f;
#pragma unroll 8
                    for (int n = 0; n < 64; ++n) { const float cr = cre[o * 64 + n], ci = cim[o * 64 + n], w1r = W1r[jj * 64 + n], w1i = W1i[jj * 64 + n];
                        s += (cr * w1r - ci * w1i) * bre[n * 16 + i] - (cr * w1i + ci * w1r) * bim[n * 16 + i]; }
                    if (j0 + jj == 0 && o == i) s += dsk[g * 16 + o];
                    KR[((size_t)(g * 64 + j0 + jj)) * 256 + (idx & 255)] = s; }
#pragma unroll 4
                for (int q = 0; q < 16; ++q) { const int idx = tid + NTHR * q, jj = idx >> 10, o = (idx >> 6) & 15, n = idx & 63;
                    const float cr = cre[o * 64 + n], ci = cim[o * 64 + n], w2r = W2r[jj * 64 + n], w2i = W2i[jj * 64 + n];
                    const unsigned pr = cvtpk(cr * w2r - ci * w2i, -(cr * w2i + ci * w2r));
                    bf16_t* trow = TTB + ((size_t)(g * 1024 + (j0 + jj) * 16 + o)) * 1152; trow[n] = (bf16_t)(pr & 0xffffu); trow[64 + n] = (bf16_t)(pr >> 16); }
#pragma unroll 4
                for (int q = 0; q < 16; ++q) { const int idx = tid + NTHR * q, jj = idx >> 10, n = (idx >> 4) & 63, i = idx & 15;
                    const float br = bre[n * 16 + i], bi = bim[n * 16 + i], w1r = W1r[jj * 64 + n], w1i = W1i[jj * 64 + n];
                    const unsigned pr = cvtpk(w1r * br - w1i * bi, w1r * bi + w1i * br); const int sI = 63 - (j0 + jj);
                    PT[((size_t)(g * 128 + n)) * 1024 + sI * 16 + i] = (bf16_t)(pr & 0xffffu); PT[((size_t)(g * 128 + 64 + n)) * 1024 + sI * 16 + i] = (bf16_t)(pr >> 16); }
            }
            __syncthreads();
        }
    }
    xcd_barrier(xbar);
    for (int rep_ = 0; rep_ < REP_P1; ++rep_) {
        PH_BEGIN
        for (int o_ = gw; o_ < 512; o_ += NGW) { float s_ = 0.f;
#pragma unroll
            for (int q = 0; q < 4; ++q) s_ += BIASP[((size_t)(o_ >> 8) * 256 + lane + 64 * q) * 256 + (o_ & 255)];
            s_ = wave_sum(s_); if (lane == 0) BIAS[o_] = s_; }
        pg8::Gemm g{HB, W13A, DM, DM, DM}; pg8::SchedGrid S; S.init(TT, 5632, G, bid); EpiSwiGLU E{ACT, SS, lds}; if (tid == 0) *(volatile LAS int*)(lds + 131072 + 1024) = -1; __syncthreads();
        pg8::gemm_phase<EpiSwiGLU, pg8::SchedGrid, true>(lds, g, S, E);
    }
    xcd_barrier(xbar);
    for (int rep_ = 0; rep_ < REP_P2; ++rep_) {
        PH_BEGIN
        pg8::Gemm g{ACT, W2A, DFF, 64, DFF, (size_t)TT * 128}; pg8::SchedGrid S; S.init(TT, DM, G, bid); EpiResid<false> E{nullptr, HB, SS, 0.5f};
        pg8::gemm_phase<EpiResid<false>, pg8::SchedGrid, true>(lds, g, S, E);
    }
    xcd_barrier(xbar);
    for (int rep_ = 0; rep_ < REP_P3; ++rep_) {
        PH_BEGIN
        pg8::Gemm g{HB, WIN, DM, DM, DM}; pg8::SchedGrid S; S.init(TT, 2048, G, bid); EpiWin E{SS, COS, SIN, QB, KC, VC, KS, VS, KW, VW, GATES, AEXT};
        pg8::gemm_phase<EpiWin, pg8::SchedGrid, true>(lds, g, S, E);
    }
    xcd_barrier(xbar);
    for (int rep_ = 0; rep_ < REP_P4; ++rep_) {
        PH_BEGIN
        { const int tn_ = (G > 128) ? G - 96 : G, tb_ = (G > 128) ? bid - 96 : bid;
          if (tb_ >= 0) {
#pragma unroll 4
        for (size_t i = (size_t)tb_ * NTHR + tid; i < (size_t)32 * 1024 * 128; i += (size_t)tn_ * NTHR) { const int ch = (int)(i & 127), rown = (int)(i >> 7), g = rown >> 10, t = (rown >> 4) & 63, o = rown & 15, s = ch >> 1, i0 = (ch & 1) * 8;
            u32x4 v = (u32x4){0u, 0u, 0u, 0u};
            if (s <= t) { const float* kr = KR + ((size_t)(g * 64 + (t - s))) * 256 + o * 16 + i0; v = pack8(*(const f32x4*)kr, *(const f32x4*)(kr + 4)); }
            if (s < 16 * ((t >> 4) + 1)) *(u32x4*)(TTB + (size_t)rown * 1152 + 128 + ch * 8) = v; }
          } }
        { pg8::Gemm g{KC, WK1, 2048, 1024, 2048}; pg8::SchedGrid S; S.init(4096, 256, G, bid); EpiCmp1 E{HC, BIAS}; pg8::gemm_phase<EpiCmp1, pg8::SchedGrid, true>(lds, g, S, E); }
        { pg8::Gemm g{VC, WV1, 2048, 1024, 2048}; pg8::SchedGrid S; S.init(4096, 256, G, (bid + G - 16) % G); EpiCmp1 E{HC + (size_t)4096 * 256, BIAS + 256}; pg8::gemm_phase<EpiCmp1, pg8::SchedGrid, true>(lds, g, S, E); }
        { pg8::Gemm g{AEXT + 128, PT, 1024, 1152, 1024}; pg8::SchedBatch S{32, 2, 1, 512, 128, G, (bid + G - 32) % G}; EpiSloc E{SLOC}; pg8::gemm_phase<EpiSloc, pg8::SchedBatch, true>(lds, g, S, E); }
    }
    xcd_barrier(xbar);
    for (int rep_ = 0; rep_ < REP_P5; ++rep_) {
        PH_BEGIN
        for (int it = gw; it < 256; it += NGW) { const int r32 = lane & 31, hi = lane >> 5, rowb = it * 32, kv = rowb >> 12; const bf16_t* W2t = kv ? WV2 : WK2;
            f32x16 a0, a1;
#pragma unroll
            for (int i = 0; i < 16; ++i) { a0[i] = 0.f; a1[i] = 0.f; }
#pragma unroll
            for (int s = 0; s < 16; ++s) { const bf16x8 af = *(const bf16x8*)(HC + (size_t)(rowb + r32) * 256 + 16 * s + 8 * hi);
                const bf16x8 b0 = *(const bf16x8*)(W2t + (size_t)r32 * 256 + 16 * s + 8 * hi), b1 = *(const bf16x8*)(W2t + (size_t)(32 + r32) * 256 + 16 * s + 8 * hi);
                a0 = MFMA32(af, b0, a0); a1 = MFMA32(af, b1, a1); }
            bf16_t* dst = kv ? VCMP : KCMP;
#pragma unroll
            for (int i = 0; i < 16; ++i) { const int R = (rowb & 4095) + crow(i, hi), c = R & 511; const unsigned pk = cvtpk(c == 511 ? 0.f : a0[i], c == 511 ? 0.f : a1[i]);
                dst[(size_t)R * 64 + r32] = (bf16_t)(pk & 0xffffu); dst[(size_t)R * 64 + 32 + r32] = (bf16_t)(pk >> 16); } }
        if (tid < 64 && bid < 128) { const int idx = bid * 64 + tid, gb = idx >> 6, n = idx & 63, g = gb >> 2, b = gb & 3;
            const float ar = A64[(g * 64 + n) * 2], ai = A64[(g * 64 + n) * 2 + 1]; float sr = 0.f, si = 0.f;
            const size_t row0 = (size_t)g * 512 + b * 128;
            for (int k0 = 0; k0 < 128; k0 += 8) { float lr[8], li[8];
#pragma unroll
                for (int q = 0; q < 8; ++q) { lr[q] = SLOC[(row0 + k0 + q) * 128 + n]; li[q] = SLOC[(row0 + k0 + q) * 128 + 64 + n]; }
#pragma unroll
                for (int q = 0; q < 8; ++q) { const unsigned pk = cvtpk(sr, si); bf16_t* ap = AEXT + (row0 + k0 + q) * 1152; ap[n] = (bf16_t)(pk & 0xffffu); ap[64 + n] = (bf16_t)(pk >> 16);
                    const float nr = ar * sr - ai * si + lr[q], ni = ar * si + ai * sr + li[q]; sr = nr; si = ni; } } }
    }
    xcd_barrier(xbar);
    for (int rep_ = 0; rep_ < REP_P6; ++rep_) {
        PH_BEGIN
        { pg8::Gemm g{AEXT, TTB, 1152, 1152, 1152}; pg8::SchedBatch S{32, 2, 4, 512, 1024, G, bid, 1}; EpiS5Y E{YP}; pg8::gemm_phase<EpiS5Y, pg8::SchedBatch, true>(lds, g, S, E); }
        const AttnP AP{QB, KS, VS, KW, VW, KCMP, VCMP, GATES, OC};
        if (G == 256) { const int bg = bid >> 5, s = bid & 31;
            for (int i = 0; i < 4; ++i) { const int qb = (i == 0) ? 127 - s : (i == 1) ? 64 + s : (i == 2) ? 63 - s : s; attn_unit(lds, AP, bg >> 1, bg & 1, qb); } }
        else { for (int L = bid; L < 1024; L += G) attn_unit(lds, AP, (L & 7) >> 1, L & 1, 127 - (L >> 3)); }
        __syncthreads();
    }
    xcd_barrier(xbar);
    for (int rep_ = 0; rep_ < REP_P7; ++rep_) {
        PH_BEGIN
        { pg8::Gemm g{YP, WGLU, 512, 512, 512}; pg8::SchedGrid S; S.init(TT, 512, G, bid); EpiGLU E{YP, kp.in[23], OC}; pg8::gemm_phase<EpiGLU, pg8::SchedGrid, true>(lds, g, S, E); }
    }
    xcd_barrier(xbar);
    for (int rep_ = 0; rep_ < REP_P8; ++rep_) {
        PH_BEGIN
        pg8::Gemm g{OC, WOUT, DM, DM, DM}; pg8::SchedGrid S; S.init(TT, DM, G, bid); EpiResid<false> E{nullptr, HB, SS, 1.0f};
        pg8::gemm_phase<EpiResid<false>, pg8::SchedGrid, true>(lds, g, S, E);
    }
    xcd_barrier(xbar);
    for (int rep_ = 0; rep_ < REP_P9; ++rep_) {
        PH_BEGIN
        pg8::Gemm g{HB, W13B, DM, DM, DM}; pg8::SchedGrid S; S.init(TT, 5632, G, bid); EpiSwiGLU E{ACT, SS, lds}; if (tid == 0) *(volatile LAS int*)(lds + 131072 + 1024) = -1; __syncthreads();
        pg8::gemm_phase<EpiSwiGLU, pg8::SchedGrid, true>(lds, g, S, E);
    }
    xcd_barrier(xbar);
    for (int rep_ = 0; rep_ < REP_P10; ++rep_) {
        PH_BEGIN
        pg8::Gemm g{ACT, W2B, DFF, 64, DFF, (size_t)TT * 128}; pg8::SchedGrid S; S.init(TT, DM, G, bid); EpiResid<false> E{nullptr, HB, SS, 0.5f};
        pg8::gemm_phase<EpiResid<false>, pg8::SchedGrid, true>(lds, g, S, E);
    }
    xcd_barrier(xbar);
    {
        PH_BEGIN
        pg8::Gemm g{PB, WPLE, 256, 256, 256}; pg8::SchedGrid S; S.init(TT, DM, G, bid); EpiStoreBf16 E{EB, DM}; pg8::gemm_phase<EpiStoreBf16, pg8::SchedGrid, true>(lds, g, S, E);
        __builtin_amdgcn_fence(__ATOMIC_ACQUIRE, "agent");
    }
    if (G == 256) {
        PH_BEGIN
        pg8::Gemm g{HB, WG, DM, DM, DM}; pg8::SchedGrid S; S.init(TT, DM, G, bid); EpiGateNorm E{SS, EB, HB, out, kp.in[32], SS2, (unsigned*)(ws + 16384), lds};
        pg8::gemm_phase<EpiGateNorm, pg8::SchedGrid, true>(lds, g, S, E);
        return;
    }
    for (int rep_ = 0; rep_ < REP_P11; ++rep_) {
        PH_BEGIN
        pg8::Gemm g{HB, WG, DM, DM, DM}; pg8::SchedGrid S; S.init(TT, DM, G, bid); EpiGate E{SS, EB, HB, OC, SS2};
        pg8::gemm_phase<EpiGate, pg8::SchedGrid, true>(lds, g, S, E);
    }
    xcd_barrier(xbar);
    for (int rep_ = 0; rep_ < REP_P12; ++rep_) {
        PH_BEGIN
        const float* gf = kp.in[32];
        for (int m = gw; m < TT; m += NGW) { float sp = (lane < 16) ? SS2[(size_t)lane * TT + m] : 0.f; sp = wave_sum(sp);
            const float r = rsqrtf(sp * (1.f / 1024.f) + RMS_EPS);
            const u32x2* hr = (const u32x2*)(OC + (size_t)m * DM) + lane; f32x4* orow = (f32x4*)(out + (size_t)m * DM) + lane;
#pragma unroll
            for (int j = 0; j < 4; ++j) { const u32x2 w = hr[64 * j]; const f32x4 gg = *((const f32x4*)gf + lane + 64 * j); f32x4 v;
                v[0] = __uint_as_float(w.x << 16); v[1] = __uint_as_float(w.x & 0xffff0000u); v[2] = __uint_as_float(w.y << 16); v[3] = __uint_as_float(w.y & 0xffff0000u);
                orow[64 * j] = v * r * gg; } }
    }
}

extern "C" void kernel_launch(void* const* d_in, const int* in_sizes, int n_in, void* d_out, int out_size, void* d_ws, size_t ws_size, hipStream_t stream) {
    static int grid = 0;
    if (grid == 0) {
        if (n_in != 33 || ws_size < WS_END) { fprintf(stderr, "kernel_launch: unexpected n_in %d / ws %zu\n", n_in, ws_size); grid = -1; return; }
        int dev = 0, cus = 0, per_cu = 0;
        hipGetDevice(&dev); hipDeviceGetAttribute(&cus, hipDeviceAttributeMultiprocessorCount, dev);
        if (hipFuncSetAttribute((const void*)mega_fwd, hipFuncAttributeMaxDynamicSharedMemorySize, LDS_BYTES) != hipSuccess) { fprintf(stderr, "hipFuncSetAttribute failed\n"); grid = -1; return; }
        if (hipOccupancyMaxActiveBlocksPerMultiprocessor(&per_cu, (const void*)mega_fwd, NTHR, LDS_BYTES) != hipSuccess || per_cu < 1) { fprintf(stderr, "occupancy query: %d\n", per_cu); per_cu = 1; }
        (void)hipGetLastError();
        grid = cus * 1;
    }
    if (grid < 0) return;
    KP kp{};
    for (int i = 0; i < 33; ++i) kp.in[i] = (const float*)d_in[i];
    kp.out = (float*)d_out; kp.ws = (unsigned char*)d_ws;
    if (hipMemsetAsync(d_ws, 0, 32768, stream) != hipSuccess) { fprintf(stderr, "kernel_launch: memset of barrier words failed\n"); return; }
    void* args[] = {&kp};
    hipError_t e = hipLaunchCooperativeKernel((const void*)mega_fwd, dim3(grid), dim3(NTHR), args, LDS_BYTES, stream);
    if (e != hipSuccess) fprintf(stderr, "cooperative launch failed: %s (grid %d)\n", hipGetErrorString(e), grid);
}
```

```cpp
#include <hip/hip_runtime.h>
#include <hip/hip_cooperative_groups.h>
#include <cstdio>
#include <cstdint>
namespace cg = cooperative_groups;

#define LAS __attribute__((address_space(3)))
#define DI __device__ __forceinline__
typedef unsigned short bf16_t;
typedef short bf16x8 __attribute__((ext_vector_type(8)));
typedef short s16x4 __attribute__((ext_vector_type(4)));
typedef float f32x4 __attribute__((ext_vector_type(4)));
typedef float f32x2 __attribute__((ext_vector_type(2)));
typedef float f32x16 __attribute__((ext_vector_type(16)));
typedef unsigned u32x4 __attribute__((ext_vector_type(4)));
typedef unsigned u32x2 __attribute__((ext_vector_type(2)));
typedef __bf16 bf16x2_t __attribute__((ext_vector_type(2)));

constexpr int TT = 32768, SEQ = 8192, DM = 1024, DFF = 2816;
constexpr float RMS_EPS = 1e-6f;
constexpr float QC2 = 0.125f * 1.4426950408889634f;
constexpr float LOG2E = 1.4426950408889634f;

constexpr size_t MiB = 1u << 20;
constexpr size_t WS_COS = 1 * MiB, WS_SIN = 2 * MiB, WS_SS = 3 * MiB, WS_KR = 5 * MiB, WS_A64 = 7 * MiB, WS_BIAS = 7 * MiB + 65536, WS_BIASP = 456 * MiB;
constexpr size_t WS_W13A = 8 * MiB, WS_W2A = 19 * MiB, WS_W13B = 25 * MiB, WS_W2B = 36 * MiB, WS_WIN = 42 * MiB, WS_WOUT = 46 * MiB, WS_WG = 48 * MiB;
constexpr size_t WS_WPLE = 50 * MiB, WS_WGLU = 50 * MiB + 524288, WS_WK1 = 51 * MiB, WS_WV1 = 52 * MiB, WS_WK2 = 53 * MiB, WS_WV2 = 53 * MiB + 65536;
constexpr size_t WS_PB = 54 * MiB, WS_HB = 70 * MiB, WS_OC = 134 * MiB, WS_TT = 198 * MiB, WS_PT = 270 * MiB, WS_E = 198 * MiB;
constexpr size_t WS_ACT = 280 * MiB;
constexpr size_t WS_Q = 280 * MiB, WS_KC = 312 * MiB, WS_VC = 320 * MiB, WS_KS = 329 * MiB, WS_VS = 337 * MiB, WS_KW = 345 * MiB, WS_VW = 353 * MiB;
constexpr size_t WS_GATES = 361 * MiB, WS_AEXT = 364 * MiB, WS_SLOC = 400 * MiB, WS_HC = 408 * MiB, WS_KCMP = 412 * MiB, WS_VCMP = 412 * MiB + 524288, WS_YP = 413 * MiB;
constexpr size_t WS_END = 459 * MiB; constexpr size_t WS_SS2 = 457 * MiB;

DI unsigned cvtpk(float lo, float hi) { f32x2 v = {lo, hi}; bf16x2_t b = __builtin_convertvector(v, bf16x2_t); return __builtin_bit_cast(unsigned, b); }
DI float sigmoidf_(float x) { return __builtin_amdgcn_rcpf(1.f + __builtin_amdgcn_exp2f(-x * LOG2E)); }
DI float gelu_tanh(float x) { const float u = x + 0.044715f * x * x * x; return x * __builtin_amdgcn_rcpf(1.f + __builtin_amdgcn_exp2f(-2.f * 0.7978845608028654f * LOG2E * u)); }
DI float bf2f(bf16_t v) { return __uint_as_float((unsigned)v << 16); }

namespace pg8 {
constexpr int BM = 256, BK = 64, HALF = 128, HTB = HALF * BK * 2, STAGE_BYTES = 8 * HTB, NXCD = 8, WGM = 8;
DI int lds_byte(int r, int c) { const int st = (r >> 4) * 2 + (c >> 5), rr = r & 15, cc = c & 31, ob = rr * 64 + cc * 2; return st * 1024 + (ob ^ (((ob >> 9) & 1) << 5)); }
DI void stage_rc(int b, int& R, int& C) { const int st = b / 1024, sb = b % 1024, swz = sb ^ (((sb >> 9) & 1) << 5); R = (st >> 1) * 16 + swz / 64; C = (st & 1) * 32 + (swz % 64) / 2; }
DI int perm32(int rho) { const int n = rho >> 4, i = rho & 15; return 8 * (i >> 2) + 4 * n + (i & 3); }

struct Unit { int pm, pn, ar, br, g, nt; };
struct Gemm { const bf16_t* A; const bf16_t* Bt; int K, lda, ldb; size_t ksA = 128; };

struct SchedGrid {
    int nM, nN, nwg, G, c;
    DI void init(int M, int N, int G_, int c_) { nM = M / BM; nN = N / BM; nwg = nM * nN; G = G_; c = c_; }
    DI bool next(int i, Unit& u) const {
        const long L = (long)i * G + c; if (L >= nwg) return false;
        int wgid = (int)L; { const int q = nwg / NXCD, r = nwg % NXCD, xcd = wgid % NXCD, off = wgid / NXCD; wgid = (xcd < r ? xcd * (q + 1) : r * (q + 1) + (xcd - r) * q) + off; }
        const int nig = WGM * nN, gid = wgid / nig, fm = gid * WGM, gsz = (nM - fm) < WGM ? (nM - fm) : WGM;
        u.pm = fm + ((wgid % nig) % gsz); u.pn = (wgid % nig) / gsz; u.ar = u.pm * BM; u.br = u.pn * BM; u.g = 0; u.nt = 0; return true;
    }
};
struct SchedBatch {
    int nb, mt, nt, aStride, bStride, G, c, ktrim = 0;
    DI bool next(int i, Unit& u) const {
        const int L = i * G + c; if (L >= nb * mt * nt) return false;
        const int g = L / (mt * nt), r = L % (mt * nt); u.g = g; u.pm = r % mt; u.pn = r / mt; u.ar = g * aStride + u.pm * BM; u.br = g * bStride + u.pn * BM; u.nt = ktrim ? 2 + 4 * (u.pn + 1) : 0; return true;
    }
};

template <class Epi, class Sched, bool ALIGN_EPI>
DI void gemm_phase(LAS unsigned char* lds, const Gemm g, const Sched& S, const Epi& E) {
    int tid = threadIdx.x; asm volatile("" : "+v"(tid));
    const int wid = __builtin_amdgcn_readfirstlane(tid >> 6), lane = tid & 63, wr = wid >> 2, wc = wid & 3, fr = lane & 15, fq = lane >> 4;
    const int K = g.K, ntdef = K / BK; int nt = ntdef;
    unsigned voffA[2], voffB[2];
#pragma unroll
    for (int i = 0; i < 2; ++i) { int R, C; stage_rc(tid * 16 + i * 8192, R, C); const int Rb = (R & ~31) + perm32(R & 31);
        voffA[i] = (unsigned)(R * g.lda + C) * 2u; voffB[i] = (unsigned)(Rb * g.ldb + C) * 2u; }
    const size_t kstep = (size_t)(BK * 2), kstepA = g.ksA;
    const size_t hstepA = (size_t)HALF * g.lda * 2, hstepB = (size_t)HALF * g.ldb * 2;
    const unsigned ldsw = (unsigned)wid * 1024u;
    const int aoff = lds_byte(wr * 64 + fr, fq * 8), boff = lds_byte(wc * 32 + fr, fq * 8);
#define PG8_SA(b, h) (((b) * 2 + (h)) * HTB)
#define PG8_SB(b, h) ((4 + (b) * 2 + (h)) * HTB)
#define PG8_STAGE(bufoff, gbase, voff) do { _Pragma("unroll") for (int _i = 0; _i < 2; ++_i) \
        __builtin_amdgcn_global_load_lds((const unsigned*)((const char*)(gbase) + (voff)[_i]), (LAS unsigned*)(lds + (bufoff) + ldsw + _i * 8192), 16, 0, 0); } while (0)
#define PG8_LDA(dst, b, h) do { _Pragma("unroll") for (int m = 0; m < 4; ++m) _Pragma("unroll") for (int k = 0; k < 2; ++k) dst[m][k] = *(const LAS bf16x8*)(lds + PG8_SA(b, h) + aoff + m * 2048 + k * 1024); } while (0)
#define PG8_LDB(dst, b, h) do { _Pragma("unroll") for (int n = 0; n < 2; ++n) _Pragma("unroll") for (int k = 0; k < 2; ++k) dst[n][k] = *(const LAS bf16x8*)(lds + PG8_SB(b, h) + boff + n * 2048 + k * 1024); } while (0)
#define PG8_MMA(ai, bj, At, Bt) do { __builtin_amdgcn_s_setprio(1); _Pragma("unroll") for (int m = 0; m < 4; ++m) _Pragma("unroll") for (int n = 0; n < 2; ++n) _Pragma("unroll") for (int k = 0; k < 2; ++k) \
        acc[ai][bj][m][n] = __builtin_amdgcn_mfma_f32_16x16x32_bf16(Bt[n][k], At[m][k], acc[ai][bj][m][n], 0, 0, 0); __builtin_amdgcn_s_setprio(0); } while (0)
#define PG8_WAIT_V(n) asm volatile("s_waitcnt vmcnt(" #n ")" ::: "memory")
#define PG8_WAIT_L(n) asm volatile("s_waitcnt lgkmcnt(" #n ")" ::: "memory")
#define PG8_BAR __builtin_amdgcn_s_barrier()
#define PG8_SCHED __builtin_amdgcn_sched_barrier(0)
    Unit cur, nxt; int ui = 0;
    if (!S.next(0, cur)) return;
    nt = cur.nt ? cur.nt : ntdef;
    f32x4 acc[2][2][4][2];
#pragma unroll
    for (int a = 0; a < 2; ++a)
#pragma unroll
        for (int b = 0; b < 2; ++b)
#pragma unroll
            for (int m = 0; m < 4; ++m)
#pragma unroll
                for (int n = 0; n < 2; ++n) acc[a][b][m][n] = (f32x4){0.f, 0.f, 0.f, 0.f};
    bf16x8 At[4][2], B0[2][2], B1[2][2];
    const char* cA = (const char*)g.A + (size_t)cur.ar * g.lda * 2; const char* cB = (const char*)g.Bt + (size_t)cur.br * g.ldb * 2;
    PG8_STAGE(PG8_SB(0, 0), cB, voffB); PG8_STAGE(PG8_SB(0, 1), cB + hstepB, voffB); PG8_STAGE(PG8_SA(0, 0), cA, voffA); PG8_STAGE(PG8_SA(0, 1), cA + hstepA, voffA);
    if (wr == 1) PG8_BAR;
    PG8_WAIT_V(2); PG8_BAR;
    PG8_STAGE(PG8_SB(1, 0), cB + kstep, voffB); PG8_STAGE(PG8_SA(1, 0), cA + kstepA, voffA); PG8_STAGE(PG8_SB(1, 1), cB + hstepB + kstep, voffB);
    PG8_WAIT_V(6); PG8_BAR;
    for (;;) {
        const bool has_next = S.next(ui + 1, nxt);
        const char* nA = has_next ? (const char*)g.A + (size_t)nxt.ar * g.lda * 2 : cA; const char* nB = has_next ? (const char*)g.Bt + (size_t)nxt.br * g.ldb * 2 : cB;
        for (int t = 0; t < nt; t += 2) {
            const bool last = (t == nt - 2);
            const char* a1 = cA + (size_t)(t + 1) * kstepA;
            const char* a2 = last ? nA : cA + (size_t)(t + 2) * kstepA; const char* b2 = last ? nB : cB + (size_t)(t + 2) * kstep;
            const char* a3 = a2 + kstepA; const char* b3 = b2 + kstep;
            PG8_LDB(B0, 0, 0); PG8_LDB(B1, 0, 1); PG8_SCHED; PG8_LDA(At, 0, 0); PG8_STAGE(PG8_SA(1, 1), a1 + hstepA, voffA);
            PG8_WAIT_V(8); PG8_WAIT_L(0); PG8_BAR; PG8_MMA(0, 0, At, B0); PG8_MMA(0, 1, At, B1); PG8_BAR; PG8_SCHED;
            PG8_LDA(At, 0, 1); PG8_STAGE(PG8_SB(0, 0), b2, voffB); PG8_STAGE(PG8_SB(0, 1), b2 + hstepB, voffB); PG8_STAGE(PG8_SA(0, 0), a2, voffA);
            PG8_WAIT_V(8); PG8_WAIT_L(0); PG8_BAR; PG8_MMA(1, 0, At, B0); PG8_MMA(1, 1, At, B1); PG8_BAR; PG8_SCHED;
            PG8_LDB(B0, 1, 0); PG8_LDB(B1, 1, 1); PG8_SCHED; PG8_LDA(At, 1, 0); PG8_STAGE(PG8_SA(0, 1), a2 + hstepA, voffA);
            PG8_WAIT_V(8); PG8_WAIT_L(0); PG8_BAR; PG8_MMA(0, 0, At, B0); PG8_MMA(0, 1, At, B1); PG8_BAR; PG8_SCHED;
            PG8_LDA(At, 1, 1); PG8_STAGE(PG8_SB(1, 0), b3, voffB); PG8_STAGE(PG8_SB(1, 1), b3 + hstepB, voffB); PG8_STAGE(PG8_SA(1, 0), a3, voffA);
            PG8_WAIT_V(8); PG8_WAIT_L(0); PG8_BAR; PG8_MMA(1, 0, At, B0); PG8_MMA(1, 1, At, B1); PG8_BAR; PG8_SCHED;
        }
        if constexpr (ALIGN_EPI) { if (wr == 0) PG8_BAR; }
        E(acc, cur, wr, wc, fr, fq);
        if (!has_next) break;
#pragma unroll
        for (int a = 0; a < 2; ++a)
#pragma unroll
            for (int b = 0; b < 2; ++b)
#pragma unroll
                for (int m = 0; m < 4; ++m)
#pragma unroll
                    for (int n = 0; n < 2; ++n) acc[a][b][m][n] = (f32x4){0.f, 0.f, 0.f, 0.f};
        cur = nxt; cA = nA; cB = nB; ++ui; nt = cur.nt ? cur.nt : ntdef;
        if constexpr (ALIGN_EPI) { if (wr == 1) PG8_BAR; }
    }
    PG8_WAIT_V(0);
    if constexpr (!ALIGN_EPI) { if (wr == 0) PG8_BAR; }
    PG8_BAR;
#undef PG8_SA
#undef PG8_SB
#undef PG8_STAGE
#undef PG8_LDA
#undef PG8_LDB
#undef PG8_MMA
#undef PG8_WAIT_V
#undef PG8_WAIT_L
#undef PG8_BAR
#undef PG8_SCHED
}
}
using pg8::Unit;
typedef f32x4 AccT[2][2][4][2];

DI void load_rowscales(const float* SS, int row0, int fq, float (&rs)[2][4]) {
#pragma unroll
    for (int ai = 0; ai < 2; ++ai)
#pragma unroll
        for (int m = 0; m < 4; ++m) { const int row = row0 + ai * 128 + m * 16; const float* p = SS + (size_t)(4 * fq) * TT + row;
            float s = (p[0] + p[TT]) + (p[2 * (size_t)TT] + p[3 * (size_t)TT]); s += __shfl_xor(s, 16); s += __shfl_xor(s, 32);
            rs[ai][m] = rsqrtf(s * (1.f / 1024.f) + RMS_EPS); }
}
DI u32x4 pack8(const f32x4 a, const f32x4 b) { u32x4 w; w.x = cvtpk(a[0], a[1]); w.y = cvtpk(a[2], a[3]); w.z = cvtpk(b[0], b[1]); w.w = cvtpk(b[2], b[3]); return w; }

struct EpiSwiGLU { bf16_t* ACT; const float* SS; LAS unsigned char* lds;
    DI void operator()(const AccT& acc, const Unit& u, int wr, int wc, int fr, int fq) const {
        LAS float* rt = (LAS float*)(lds + 131072); volatile LAS int* tag = (volatile LAS int*)(lds + 131072 + 1024);
        const int tid = (wr * 4 + wc) * 64 + fq * 16 + fr;
        if (tag[0] != u.pm) {
            if (tid < 256) { const float* p = SS + (size_t)u.pm * 256 + tid; float sum = 0.f;
#pragma unroll
                for (int k = 0; k < 16; ++k) sum += p[(size_t)k * TT];
                rt[tid] = rsqrtf(sum * (1.f / 1024.f) + RMS_EPS); }
            asm volatile("s_waitcnt lgkmcnt(0)" ::: "memory"); __builtin_amdgcn_s_barrier(); asm volatile("" ::: "memory");
            if (tid == 0) tag[0] = u.pm;
        }
        const int row0 = u.pm * 256 + wr * 64 + fr;
        const int col = u.pn * 128 + wc * 32 + 8 * fq;
#pragma unroll
        for (int ai = 0; ai < 2; ++ai)
#pragma unroll
            for (int m = 0; m < 4; ++m) { const int row = row0 + ai * 128 + m * 16; const float r = rt[ai * 128 + wr * 64 + m * 16 + fr]; f32x4 o[2];
#pragma unroll
                for (int n = 0; n < 2; ++n)
#pragma unroll
                    for (int e = 0; e < 4; ++e) { const float gg = acc[ai][0][m][n][e] * r, uu = acc[ai][1][m][n][e] * r; o[n][e] = gg * sigmoidf_(gg) * uu; }
                *(u32x4*)(ACT + ((size_t)(col >> 6) * TT + row) * 64 + (col & 63)) = pack8(o[0], o[1]); }
    }
};
DI void unpack8(const u32x4 w, f32x4& a, f32x4& b) { a[0] = __uint_as_float(w.x << 16); a[1] = __uint_as_float(w.x & 0xffff0000u); a[2] = __uint_as_float(w.y << 16); a[3] = __uint_as_float(w.y & 0xffff0000u);
    b[0] = __uint_as_float(w.z << 16); b[1] = __uint_as_float(w.z & 0xffff0000u); b[2] = __uint_as_float(w.w << 16); b[3] = __uint_as_float(w.w & 0xffff0000u); }
DI float sumsq8(const f32x4 v0, const f32x4 v1) { return (v0[0] * v0[0] + v0[1] * v0[1]) + (v0[2] * v0[2] + v0[3] * v0[3]) + (v1[0] * v1[0] + v1[1] * v1[1]) + (v1[2] * v1[2] + v1[3] * v1[3]); }
template <bool BASEF32> struct EpiResid { const float* basef; bf16_t* Hb; float* SSout; float alpha;
    DI void operator()(const AccT& acc, const Unit& u, int wr, int wc, int fr, int fq) const {
        const int row0 = u.pm * 256 + wr * 64 + fr; const int colb = u.pn * 256 + wc * 32 + 8 * fq;
#pragma unroll
        for (int ai = 0; ai < 2; ++ai)
#pragma unroll
        for (int mh = 0; mh < 2; ++mh) {
            f32x4 pf0[2][2], pf1[2][2]; u32x4 ph[2][2];
#pragma unroll
            for (int mm = 0; mm < 2; ++mm)
#pragma unroll
                for (int bj = 0; bj < 2; ++bj) { const size_t off = (size_t)(row0 + ai * 128 + (2 * mh + mm) * 16) * DM + colb + bj * 128;
                    if (BASEF32) { pf0[mm][bj] = *(const f32x4*)(basef + off); pf1[mm][bj] = *(const f32x4*)(basef + off + 4); } else ph[mm][bj] = *(const u32x4*)(Hb + off); }
#pragma unroll
            for (int mm = 0; mm < 2; ++mm) { const int m = 2 * mh + mm; const int row = row0 + ai * 128 + m * 16; float q = 0.f;
#pragma unroll
                for (int bj = 0; bj < 2; ++bj) { const size_t off = (size_t)row * DM + colb + bj * 128; f32x4 b0, b1;
                    if (BASEF32) { b0 = pf0[mm][bj]; b1 = pf1[mm][bj]; } else unpack8(ph[mm][bj], b0, b1);
                    const f32x4 v0 = b0 + acc[ai][bj][m][0] * alpha, v1 = b1 + acc[ai][bj][m][1] * alpha;
                    *(u32x4*)(Hb + off) = pack8(v0, v1); q += sumsq8(v0, v1); }
                q += __shfl_xor(q, 16); q += __shfl_xor(q, 32);
                if (fq == 0) SSout[(size_t)(u.pn * 4 + wc) * TT + row] = q; }
        }
    }
};
struct EpiGate { const float* SS; const bf16_t* Eb; const bf16_t* Hb; bf16_t* H4; float* SSout;
    DI void operator()(const AccT& acc, const Unit& u, int wr, int wc, int fr, int fq) const {
        float rs[2][4]; const int row0 = u.pm * 256 + wr * 64 + fr; load_rowscales(SS, row0, fq, rs); const int colb = u.pn * 256 + wc * 32 + 8 * fq;
#pragma unroll
        for (int ai = 0; ai < 2; ++ai)
#pragma unroll
        for (int mh = 0; mh < 2; ++mh) {
            u32x4 pe[2][2], ph[2][2];
#pragma unroll
            for (int mm = 0; mm < 2; ++mm)
#pragma unroll
                for (int bj = 0; bj < 2; ++bj) { const size_t off = (size_t)(row0 + ai * 128 + (2 * mh + mm) * 16) * DM + colb + bj * 128; pe[mm][bj] = *(const u32x4*)(Eb + off); ph[mm][bj] = *(const u32x4*)(Hb + off); }
#pragma unroll
            for (int mm = 0; mm < 2; ++mm) { const int m = 2 * mh + mm; const int row = row0 + ai * 128 + m * 16; const float r = rs[ai][m]; float q = 0.f;
#pragma unroll
                for (int bj = 0; bj < 2; ++bj) { const size_t off = (size_t)row * DM + colb + bj * 128;
                    f32x4 e0, e1, b0, b1; unpack8(pe[mm][bj], e0, e1); unpack8(ph[mm][bj], b0, b1);
#pragma unroll
                    for (int e = 0; e < 4; ++e) { b0[e] += sigmoidf_(acc[ai][bj][m][0][e] * r) * e0[e]; b1[e] += sigmoidf_(acc[ai][bj][m][1][e] * r) * e1[e]; }
                    *(u32x4*)(H4 + off) = pack8(b0, b1); q += sumsq8(b0, b1); }
                q += __shfl_xor(q, 16); q += __shfl_xor(q, 32);
                if (fq == 0) SSout[(size_t)(u.pn * 4 + wc) * TT + row] = q; }
        }
    }
};
struct EpiGateNorm { const float* SS; const bf16_t* Eb; const bf16_t* Hb; float* out; const float* gfin; float* part; unsigned* cnt; LAS unsigned char* lds;
    DI void operator()(AccT& acc, const Unit& u, int wr, int wc, int fr, int fq) const {
        float rs[2][4]; const int row0 = u.pm * 256 + wr * 64 + fr; load_rowscales(SS, row0, fq, rs); const int colb = u.pn * 256 + wc * 32 + 8 * fq;
        LAS float* red = (LAS float*)(lds + 131072); LAS float* rf = red + 1024;
        const int tid = (wr * 4 + wc) * 64 + fq * 16 + fr;
#pragma unroll
        for (int ai = 0; ai < 2; ++ai)
#pragma unroll
        for (int mh = 0; mh < 2; ++mh) {
            u32x4 pe[2][2], ph[2][2];
#pragma unroll
            for (int mm = 0; mm < 2; ++mm)
#pragma unroll
                for (int bj = 0; bj < 2; ++bj) { const size_t off = (size_t)(row0 + ai * 128 + (2 * mh + mm) * 16) * DM + colb + bj * 128; pe[mm][bj] = *(const u32x4*)(Eb + off); ph[mm][bj] = *(const u32x4*)(Hb + off); }
#pragma unroll
            for (int mm = 0; mm < 2; ++mm) { const int m = 2 * mh + mm; const float r = rs[ai][m]; float q = 0.f;
#pragma unroll
                for (int bj = 0; bj < 2; ++bj) { f32x4 e0, e1, b0, b1; unpack8(pe[mm][bj], e0, e1); unpack8(ph[mm][bj], b0, b1);
#pragma unroll
                    for (int e = 0; e < 4; ++e) { b0[e] += sigmoidf_(acc[ai][bj][m][0][e] * r) * e0[e]; b1[e] += sigmoidf_(acc[ai][bj][m][1][e] * r) * e1[e]; }
                    acc[ai][bj][m][0] = b0; acc[ai][bj][m][1] = b1; q += sumsq8(b0, b1); }
                q += __shfl_xor(q, 16); q += __shfl_xor(q, 32);
                if (fq == 0) red[(ai * 128 + wr * 64 + m * 16 + fr) * 4 + wc] = q; }
        }
        asm volatile("s_waitcnt lgkmcnt(0)" ::: "memory"); __builtin_amdgcn_s_barrier(); asm volatile("" ::: "memory");
        if (tid < 256) { const float s4 = (red[tid * 4] + red[tid * 4 + 1]) + (red[tid * 4 + 2] + red[tid * 4 + 3]);
            __hip_atomic_store(part + (size_t)u.pn * TT + u.pm * 256 + tid, s4, __ATOMIC_RELAXED, __HIP_MEMORY_SCOPE_AGENT); }
        asm volatile("s_waitcnt vmcnt(0) lgkmcnt(0)" ::: "memory"); __builtin_amdgcn_s_barrier(); asm volatile("" ::: "memory");
        if (tid == 0) { unsigned* c = cnt + u.pm * 16; __hip_atomic_fetch_add(c, 1u, __ATOMIC_RELAXED, __HIP_MEMORY_SCOPE_AGENT);
            unsigned sp = 0; while (__hip_atomic_load(c, __ATOMIC_RELAXED, __HIP_MEMORY_SCOPE_AGENT) < 4u) { __builtin_amdgcn_s_sleep(2); if (++sp > (1u << 22)) break; }
            __builtin_amdgcn_fence(__ATOMIC_ACQUIRE, "agent"); asm volatile("s_waitcnt vmcnt(0)" ::: "memory"); }
        asm volatile("s_waitcnt vmcnt(0) lgkmcnt(0)" ::: "memory"); __builtin_amdgcn_s_barrier(); asm volatile("" ::: "memory");
        if (tid < 256) { float s4 = 0.f;
#pragma unroll
            for (int k = 0; k < 4; ++k) s4 += __hip_atomic_load(part + (size_t)k * TT + u.pm * 256 + tid, __ATOMIC_RELAXED, __HIP_MEMORY_SCOPE_AGENT);
            rf[tid] = rsqrtf(s4 * (1.f / 1024.f) + RMS_EPS); }
        asm volatile("s_waitcnt vmcnt(0) lgkmcnt(0)" ::: "memory"); __builtin_amdgcn_s_barrier(); asm volatile("" ::: "memory");
#pragma unroll
        for (int bj = 0; bj < 2; ++bj) { const f32x4 g0 = *(const f32x4*)(gfin + colb + bj * 128), g1 = *(const f32x4*)(gfin + colb + bj * 128 + 4);
#pragma unroll
            for (int ai = 0; ai < 2; ++ai)
#pragma unroll
                for (int m = 0; m < 4; ++m) { const int rl = ai * 128 + wr * 64 + m * 16 + fr; const float r = rf[rl]; float* op = out + (size_t)(u.pm * 256 + rl) * DM + colb + bj * 128;
                    *(f32x4*)op = acc[ai][bj][m][0] * r * g0; *(f32x4*)(op + 4) = acc[ai][bj][m][1] * r * g1; } }
        asm volatile("s_waitcnt lgkmcnt(0)" ::: "memory"); __builtin_amdgcn_s_barrier(); asm volatile("" ::: "memory");
    }
};
struct EpiStoreBf16 { bf16_t* O; int ldc;
    DI void operator()(const AccT& acc, const Unit& u, int wr, int wc, int fr, int fq) const {
        const int row0 = u.pm * 256 + wr * 64 + fr;
#pragma unroll
        for (int ai = 0; ai < 2; ++ai)
#pragma unroll
            for (int m = 0; m < 4; ++m) { const int row = row0 + ai * 128 + m * 16;
#pragma unroll
                for (int bj = 0; bj < 2; ++bj) *(u32x4*)(O + (size_t)row * ldc + u.pn * 256 + bj * 128 + wc * 32 + 8 * fq) = pack8(acc[ai][bj][m][0], acc[ai][bj][m][1]); }
    }
};
struct EpiWin { const float* SS; const float* cs; const float* sn; bf16_t *Q, *KC, *VC, *KS, *VS, *KW, *VW; float* gates; bf16_t* Aext;
    DI void operator()(const AccT& acc, const Unit& u, int wr, int wc, int fr, int fq) const {
        float rs[2][4]; const int row0 = u.pm * 256 + wr * 64 + fr; load_rowscales(SS, row0, fq, rs);
        const int pn = u.pn; const bool ropet = (pn < 3 || (pn == 3 && wc < 2));
        f32x4 ivr[2]; ivr[0] = *(const f32x4*)(cs + 8 * fq); ivr[1] = *(const f32x4*)(cs + 8 * fq + 4);
#pragma unroll
        for (int aim = 0; aim < 4; ++aim) { const int ai = aim >> 1, mh = aim & 1;
            f32x4 pc[2][2], psn[2][2];
            if (ropet) {
#pragma unroll
                for (int mm = 0; mm < 2; ++mm) { const float tf = (float)((row0 + ai * 128 + (2 * mh + mm) * 16) & 8191);
#pragma unroll
                    for (int n = 0; n < 2; ++n)
#pragma unroll
                        for (int e = 0; e < 4; ++e) { const float rev = __builtin_amdgcn_fractf(tf * ivr[n][e]); pc[mm][n][e] = __builtin_amdgcn_cosf(rev); psn[mm][n][e] = __builtin_amdgcn_sinf(rev); } } }
#pragma unroll
            for (int mm = 0; mm < 2; ++mm) { const int m = 2 * mh + mm; const int row = row0 + ai * 128 + m * 16; const float r = rs[ai][m]; const int b = row >> 13, t = row & 8191;
                if (ropet) {
                    const int d0 = 8 * fq; f32x4 y1[2], y2[2];
#pragma unroll
                    for (int n = 0; n < 2; ++n) { const f32x4 c = pc[mm][n], s = psn[mm][n];
                        const f32x4 x1 = acc[ai][0][m][n] * r, x2 = acc[ai][1][m][n] * r; y1[n] = x1 * c - x2 * s; y2[n] = x1 * s + x2 * c; }
                    bf16_t* ptr;
                    if (pn < 2) { const int head = 4 * pn + wc; ptr = Q + ((size_t)(b * 8 + head) * SEQ + t) * 64;
#pragma unroll
                        for (int n = 0; n < 2; ++n) { y1[n] = y1[n] * QC2; y2[n] = y2[n] * QC2; } }
                    else if (pn == 2) { ptr = (wc < 2 ? KC : KS) + ((size_t)(b * 2 + (wc & 1)) * SEQ + t) * 64; }
                    else { ptr = KW + ((size_t)(b * 2 + wc) * SEQ + t) * 64; }
                    *(u32x4*)(ptr + d0) = pack8(y1[0], y1[1]); *(u32x4*)(ptr + 32 + d0) = pack8(y2[0], y2[1]);
                } else if (pn == 3) {
#pragma unroll
                    for (int bj = 0; bj < 2; ++bj) *(u32x4*)(VC + ((size_t)(b * 2 + bj) * SEQ + t) * 64 + (wc - 2) * 32 + 8 * fq) = pack8(acc[ai][bj][m][0] * r, acc[ai][bj][m][1] * r);
                } else if (pn == 4) {
#pragma unroll
                    for (int bj = 0; bj < 2; ++bj) *(u32x4*)((bj ? VW : VS) + ((size_t)(b * 2 + (wc >> 1)) * SEQ + t) * 64 + (wc & 1) * 32 + 8 * fq) = pack8(acc[ai][bj][m][0] * r, acc[ai][bj][m][1] * r);
                } else if (pn < 7) {
#pragma unroll
                    for (int bj = 0; bj < 2; ++bj) { const int col = (pn - 5) * 256 + bj * 128 + wc * 32 + 8 * fq, gg = col >> 4, i0 = col & 15;
                        *(u32x4*)(Aext + ((size_t)(gg * 512 + b * 128 + (t >> 6))) * 1152 + 128 + (t & 63) * 16 + i0) = pack8(acc[ai][bj][m][0] * r, acc[ai][bj][m][1] * r); }
                } else {
                    if (wc == 0 && fq < 3) {
#pragma unroll
                        for (int n = 0; n < 2; ++n)
#pragma unroll
                            for (int e = 0; e < 4; ++e) gates[(size_t)row * 24 + 8 * fq + 4 * n + e] = sigmoidf_(acc[ai][0][m][n][e] * r); }
                }
            }
        }
    }
};
struct EpiCmp1 { bf16_t* Hc; const float* bias;
    DI void operator()(const AccT& acc, const Unit& u, int wr, int wc, int fr, int fq) const {
        const int row0 = u.pm * 256 + wr * 64 + fr;
#pragma unroll
        for (int bj = 0; bj < 2; ++bj) { const int col = bj * 128 + wc * 32 + 8 * fq; const f32x4 bb0 = *(const f32x4*)(bias + col), bb1 = *(const f32x4*)(bias + col + 4);
#pragma unroll
            for (int ai = 0; ai < 2; ++ai)
#pragma unroll
                for (int m = 0; m < 4; ++m) { const int row = row0 + ai * 128 + m * 16; f32x4 o0, o1;
#pragma unroll
                    for (int e = 0; e < 4; ++e) { o0[e] = gelu_tanh(acc[ai][bj][m][0][e] + bb0[e]); o1[e] = gelu_tanh(acc[ai][bj][m][1][e] + bb1[e]); }
                    *(u32x4*)(Hc + (size_t)row * 256 + col) = pack8(o0, o1); } }
    }
};
struct EpiSloc { float* Sloc;
    DI void operator()(const AccT& acc, const Unit& u, int wr, int wc, int fr, int fq) const {
        const int row0 = u.g * 512 + u.pm * 256 + wr * 64 + fr;
#pragma unroll
        for (int ai = 0; ai < 2; ++ai)
#pragma unroll
            for (int m = 0; m < 4; ++m) { const int row = row0 + ai * 128 + m * 16; float* p = Sloc + (size_t)row * 128 + wc * 32 + 8 * fq;
                *(f32x4*)p = acc[ai][0][m][0]; *(f32x4*)(p + 4) = acc[ai][0][m][1]; }
    }
};
struct EpiS5Y { bf16_t* Yp;
    DI void operator()(const AccT& acc, const Unit& u, int wr, int wc, int fr, int fq) const {
        const int row0 = u.pm * 256 + wr * 64 + fr;
#pragma unroll
        for (int ai = 0; ai < 2; ++ai)
#pragma unroll
            for (int m = 0; m < 4; ++m) { const int lr = row0 + ai * 128 + m * 16, b = lr >> 7, ch = lr & 127;
#pragma unroll
                for (int bj = 0; bj < 2; ++bj) { const int cn = u.pn * 256 + bj * 128 + wc * 32 + 8 * fq, t = cn >> 4, o0 = cn & 15; f32x4 y0, y1;
#pragma unroll
                    for (int e = 0; e < 4; ++e) { y0[e] = gelu_tanh(acc[ai][bj][m][0][e]); y1[e] = gelu_tanh(acc[ai][bj][m][1][e]); }
                    *(u32x4*)(Yp + ((size_t)(b * SEQ + ch * 64 + t)) * 512 + u.g * 16 + o0) = pack8(y0, y1); } }
    }
};
struct EpiGLU { const bf16_t* Yp; const float* bglu; bf16_t* Oc;
    DI void operator()(const AccT& acc, const Unit& u, int wr, int wc, int fr, int fq) const {
        const int row0 = u.pm * 256 + wr * 64 + fr;
#pragma unroll
        for (int bj = 0; bj < 2; ++bj) { const int col = u.pn * 256 + bj * 128 + wc * 32 + 8 * fq; const f32x4 bb0 = *(const f32x4*)(bglu + col), bb1 = *(const f32x4*)(bglu + col + 4);
#pragma unroll
            for (int ai = 0; ai < 2; ++ai)
#pragma unroll
                for (int m = 0; m < 4; ++m) { const int row = row0 + ai * 128 + m * 16; const u32x4 yv = *(const u32x4*)(Yp + (size_t)row * 512 + col); f32x4 o0, o1;
#pragma unroll
                    for (int e = 0; e < 4; ++e) { const unsigned w0 = yv[e >> 1], w1 = yv[2 + (e >> 1)];
                        const float y0 = (e & 1) ? __uint_as_float(w0 & 0xffff0000u) : __uint_as_float(w0 << 16), y1 = (e & 1) ? __uint_as_float(w1 & 0xffff0000u) : __uint_as_float(w1 << 16);
                        o0[e] = y0 * sigmoidf_(acc[ai][bj][m][0][e] + bb0[e]); o1[e] = y1 * sigmoidf_(acc[ai][bj][m][1][e] + bb1[e]); }
                    *(u32x4*)(Oc + (size_t)row * DM + 512 + col) = pack8(o0, o1); } }
    }
};

struct KP { const float* in[33]; float* out; unsigned char* ws; };

DI int win_src_col(int n) {
    const int pn = n >> 8, bj = (n >> 7) & 1, wc = (n >> 5) & 3, d = n & 31;
    if (pn < 2) return (4 * pn + wc) * 64 + 32 * bj + d;
    if (pn == 2) return (wc < 2 ? 512 + wc * 64 : 768 + (wc - 2) * 64) + 32 * bj + d;
    if (pn == 3) return (wc < 2) ? 1024 + wc * 64 + 32 * bj + d : 640 + bj * 64 + (wc - 2) * 32 + d;
    if (pn == 4) return (bj ? 1152 : 896) + wc * 32 + d;
    if (pn < 7) return 1304 + (pn - 5) * 256 + (n & 255);
    return ((n & 255) < 24) ? 1280 + (n & 255) : -1;
}
DI void transpose_item(int kind, const float* W, const float* W3, int Nsrc, int K, int Np, const float* sc, bf16_t* Bt, LAS float* scr, int item, int lane) {
    const int nblk = Np / 32, kb = item / nblk, nb = item % nblk, k0 = 64 * kb, n0 = 32 * nb;
    const int n = n0 + (lane & 31); const float* src = W; int col = n;
    if (kind == 1) { const int j = n & 255; col = 128 * (n >> 8) + (j & 127); src = (j < 128) ? W : W3; }
    else if (kind == 2) col = win_src_col(n);
    const bool valid = col >= 0; const float* p = src + (valid ? col : 0) + (size_t)(k0 + (lane >> 5)) * Nsrc;
    float v[32];
#pragma unroll
    for (int i = 0; i < 32; ++i) v[i] = __builtin_nontemporal_load(p + (size_t)(2 * i) * Nsrc);
#pragma unroll
    for (int i = 0; i < 32; ++i) scr[(2 * i + (lane >> 5)) * 33 + (lane & 31)] = valid ? v[i] : 0.f;
    asm volatile("s_waitcnt lgkmcnt(0)" ::: "memory");
    const int c = lane & 7;
    f32x4 sc0 = (f32x4){1.f, 1.f, 1.f, 1.f}, sc1 = sc0;
    if (sc) { sc0 = *(const f32x4*)(sc + k0 + 8 * c); sc1 = *(const f32x4*)(sc + k0 + 8 * c + 4); }
#pragma unroll
    for (int j = 0; j < 4; ++j) { const int nn = (lane >> 3) + 8 * j; const LAS float* s = scr + (8 * c) * 33 + nn;
        u32x4 o; o.x = cvtpk(s[0 * 33] * sc0[0], s[1 * 33] * sc0[1]); o.y = cvtpk(s[2 * 33] * sc0[2], s[3 * 33] * sc0[3]); o.z = cvtpk(s[4 * 33] * sc1[0], s[5 * 33] * sc1[1]); o.w = cvtpk(s[6 * 33] * sc1[2], s[7 * 33] * sc1[3]);
        *(u32x4*)(Bt + (size_t)(n0 + nn) * K + k0 + 8 * c) = o; }
    asm volatile("s_waitcnt lgkmcnt(0)" ::: "memory");
}
DI float wave_sum(float v) {
#pragma unroll
    for (int o = 1; o < 64; o <<= 1) v += __shfl_xor(v, o);
    return v;
}
DI void sincos_d(double x, double& s, double& c) {
    const double TWO_PI_HI = 6.283185307179586232, TWO_PI_LO = 2.4492935982947064e-16, INV2PI = 0.15915494309189533577;
    const double k = __builtin_rint(x * INV2PI); double r = (x - k * TWO_PI_HI) - k * TWO_PI_LO;
    const double q = __builtin_rint(r * 0.63661977236758134308); const int qi = (int)q;
    const double y = (r - q * 1.5707963267948965580) - q * 6.1232339957367660e-17; const double y2 = y * y;
    double sp = 1.0 / 6227020800.0; sp = sp * y2 - 1.0 / 39916800.0; sp = sp * y2 + 1.0 / 362880.0; sp = sp * y2 - 1.0 / 5040.0; sp = sp * y2 + 1.0 / 120.0; sp = sp * y2 - 1.0 / 6.0; sp = sp * y2 + 1.0;
    double cp = -1.0 / 87178291200.0; cp = cp * y2 + 1.0 / 479001600.0; cp = cp * y2 - 1.0 / 3628800.0; cp = cp * y2 + 1.0 / 40320.0; cp = cp * y2 - 1.0 / 720.0; cp = cp * y2 + 1.0 / 24.0; cp = cp * y2 - 0.5; cp = cp * y2 + 1.0;
    const double sy = sp * y, cy = cp;
    switch (qi & 3) { case 0: s = sy; c = cy; break; case 1: s = cy; c = -sy; break; case 2: s = -sy; c = -cy; break; default: s = -cy; c = sy; break; }
}

constexpr int AT_KL = 0, AT_VL = 9216, AT_IMP = 18432, AT_SEL = AT_IMP + 32768, AT_BLIST = AT_SEL + 1024, AT_NL = AT_BLIST + 512;
constexpr int AT_OTP = AT_NL + 16;
DI int crow(int r, int hi) { return (r & 3) + 8 * (r >> 2) + 4 * hi; }
#define MFMA32(a, b, c) __builtin_amdgcn_mfma_f32_32x32x16_bf16((a), (b), (c), 0, 0, 0)
DI s16x4 tr_rd(LAS const unsigned char* p) { typedef short v4s __attribute__((ext_vector_type(4))); return __builtin_bit_cast(s16x4, __builtin_amdgcn_ds_read_tr16_b64_v4i16((LAS v4s*)p)); }
DI bf16x8 packp(const f32x16& x, int s) { u32x4 p; p.x = cvtpk(x[8 * s], x[8 * s + 1]); p.y = cvtpk(x[8 * s + 2], x[8 * s + 3]); p.z = cvtpk(x[8 * s + 4], x[8 * s + 5]); p.w = cvtpk(x[8 * s + 6], x[8 * s + 7]); return __builtin_bit_cast(bf16x8, p); }

struct AttnP { const bf16_t *Q, *KS, *VS, *KW, *VW, *KCc, *VCc; const float* gates; bf16_t* Oc; };

DI void qk_tile(LAS const unsigned char* Kl, const bf16x8 (&qr)[4], const f32x16& c0, int r32, int hi, f32x16& p0, f32x16& p1) {
    { const bf16x8 a0 = *(const LAS bf16x8*)(Kl + r32 * 144 + (8 * hi) * 2), a1 = *(const LAS bf16x8*)(Kl + (32 + r32) * 144 + (8 * hi) * 2);
      p0 = MFMA32(a0, qr[0], c0); p1 = MFMA32(a1, qr[0], c0); }
#pragma unroll
    for (int s = 1; s < 4; ++s) { const bf16x8 a0 = *(const LAS bf16x8*)(Kl + r32 * 144 + (16 * s + 8 * hi) * 2), a1 = *(const LAS bf16x8*)(Kl + (32 + r32) * 144 + (16 * s + 8 * hi) * 2);
        p0 = MFMA32(a0, qr[s], p0); p1 = MFMA32(a1, qr[s], p1); }
}
template <int MODE>
DI void attn_branch(LAS unsigned char* lds, const bf16_t* Kg, const bf16_t* Vg, int nblk, int jfirst, int cur, const bf16x8 (&qr)[4], int t, int tl, float& m_run, float& l_run, f32x16 (&o)[2]) {
    int tid = threadIdx.x; asm volatile("" : "+v"(tid));
    const int lane = tid & 63, r32 = lane & 31, hi = lane >> 5;
    LAS unsigned char* Kl = lds + AT_KL; LAS unsigned char* Vl = lds + AT_VL;
    LAS const int* blist = (LAS const int*)(lds + AT_BLIST); LAS const unsigned short* sel16 = (LAS const unsigned short*)(lds + AT_SEL);
    const int cmax = (t >= 31) ? ((t - 31) >> 4) : -1;
    float mref = 0.f, l = 0.f; bool first = true; f32x16 negm;
#pragma unroll
    for (int i = 0; i < 16; ++i) { o[0][i] = 0.f; o[1][i] = 0.f; negm[i] = 0.f; }
    const int ldoff = tid * 8, stoff = (tid >> 3) * 144 + (tid & 7) * 16;
    const int q4 = (lane & 15) >> 2, pp = lane & 3, blk = (lane >> 4) & 1;
    int j = (MODE == 1) ? blist[0] : jfirst;
    u32x4 kreg = *(const u32x4*)(Kg + (size_t)j * 4096 + ldoff), vreg = *(const u32x4*)(Vg + (size_t)j * 4096 + ldoff);
    for (int it = 0; it < nblk; ++it) {
        __syncthreads();
        *(LAS u32x4*)(Kl + stoff) = kreg; *(LAS u32x4*)(Vl + stoff) = vreg;
        __syncthreads();
        const int jc = j;
        if (it + 1 < nblk) { j = (MODE == 1) ? blist[it + 1] : jfirst + it + 1; kreg = *(const u32x4*)(Kg + (size_t)j * 4096 + ldoff); vreg = *(const u32x4*)(Vg + (size_t)j * 4096 + ldoff); }
        bool sel = true;
        if (MODE == 1) { const unsigned w = sel16[tl * 8 + (jc >> 4)]; sel = ((w >> (jc & 15)) & 1u) != 0u; if (!__any(sel)) continue; }
        f32x16 p0, p1; qk_tile(Kl, qr, negm, r32, hi, p0, p1);
        if (MODE == 0) {
#pragma unroll
            for (int i = 0; i < 16; ++i) { const int c = 64 * jc + crow(i, hi); if (c > cmax) p0[i] = -1e30f; if (c + 32 > cmax) p1[i] = -1e30f; }
        } else {
            if (jc == cur) {
#pragma unroll
                for (int i = 0; i < 16; ++i) { const int kk = crow(i, hi); if (kk > tl) p0[i] = -1e30f; if (kk + 32 > tl) p1[i] = -1e30f; }
            } else if (MODE == 2 && jc == cur - 8) {
#pragma unroll
                for (int i = 0; i < 16; ++i) { const int kk = crow(i, hi); if (kk <= tl) p0[i] = -1e30f; if (kk + 32 <= tl) p1[i] = -1e30f; }
            }
        }
        float mx = fmaxf(fmaxf(p0[0], p0[1]), p1[0]), my = fmaxf(fmaxf(p0[2], p0[3]), p1[1]);
        mx = fmaxf(fmaxf(mx, p1[2]), p1[3]);
#pragma unroll
        for (int i = 4; i < 16; i += 4) { mx = fmaxf(fmaxf(mx, p0[i]), p0[i + 1]); my = fmaxf(fmaxf(my, p0[i + 2]), p0[i + 3]); mx = fmaxf(fmaxf(mx, p1[i]), p1[i + 1]); my = fmaxf(fmaxf(my, p1[i + 2]), p1[i + 3]); }
        float rm = fmaxf(mx, my); rm = fmaxf(rm, __shfl_xor(rm, 32));
        if (first || __any(rm > 8.f)) {
            const float dl = first ? fmaxf(rm, -100.f) : fmaxf(rm, 0.f);
            mref += dl;
#pragma unroll
            for (int i = 0; i < 16; ++i) { p0[i] -= dl; p1[i] -= dl; negm[i] = -mref; }
            const float f = __builtin_amdgcn_exp2f(-dl); l *= f;
#pragma unroll
            for (int i = 0; i < 16; ++i) { o[0][i] *= f; o[1][i] *= f; }
            first = false;
        }
        float ps = 0.f, pt = 0.f;
#pragma unroll
        for (int i = 0; i < 16; ++i) { p0[i] = __builtin_amdgcn_exp2f(p0[i]); p1[i] = __builtin_amdgcn_exp2f(p1[i]); ps += p0[i]; pt += p1[i]; }
        l += sel ? (ps + pt) : 0.f;
        u32x4 pw[4];
        pw[0] = __builtin_bit_cast(u32x4, packp(p0, 0)); pw[1] = __builtin_bit_cast(u32x4, packp(p0, 1)); pw[2] = __builtin_bit_cast(u32x4, packp(p1, 0)); pw[3] = __builtin_bit_cast(u32x4, packp(p1, 1));
        if (MODE == 1) { const unsigned sm = sel ? 0xffffffffu : 0u;
#pragma unroll
            for (int k = 0; k < 4; ++k) { pw[k].x &= sm; pw[k].y &= sm; pw[k].z &= sm; pw[k].w &= sm; } }
#pragma unroll
        for (int dblk = 0; dblk < 2; ++dblk)
#pragma unroll
            for (int ks = 0; ks < 4; ++ks) { const int rb = 32 * (ks >> 1) + 16 * (ks & 1) + 4 * hi + q4;
                LAS const unsigned char* vp = Vl + rb * 144 + (32 * dblk + 16 * blk) * 2 + 8 * pp;
                const s16x4 lo = tr_rd(vp), hh = tr_rd(vp + 8 * 144);
                const bf16x8 vf = __builtin_shufflevector(lo, hh, 0, 1, 2, 3, 4, 5, 6, 7);
                o[dblk] = MFMA32(vf, __builtin_bit_cast(bf16x8, pw[ks]), o[dblk]); }
    }
    m_run = mref; l_run = l;
}

template <int MODE>
DI void attn_branch_fast(LAS unsigned char* lds, const bf16_t* Kg, const bf16_t* Vg, int nblk, int jfirst, int cur, const bf16x8 (&qr)[4], int t, int tl, float& m_run, float& l_run, f32x16 (&o)[2]) {
    int tid = threadIdx.x; asm volatile("" : "+v"(tid));
    const int lane = tid & 63, r32 = lane & 31, hi = lane >> 5;
    LAS unsigned char* Kl = lds + AT_KL; LAS unsigned char* Vl = lds + AT_VL;
    LAS const int* blist = (LAS const int*)(lds + AT_BLIST); LAS const unsigned short* sel16 = (LAS const unsigned short*)(lds + AT_SEL);
    const int cmax = (t >= 31) ? ((t - 31) >> 4) : -1;
    f32x16 lacc; bf16x8 ones;
#pragma unroll
    for (int i = 0; i < 8; ++i) ones[i] = (short)0x3F80;
    f32x16 negm;
#pragma unroll
    for (int i = 0; i < 16; ++i) { o[0][i] = 0.f; o[1][i] = 0.f; negm[i] = 0.f; lacc[i] = 0.f; }
    const int ldoff = tid * 8, stoff = (tid >> 3) * 144 + (tid & 7) * 16;
    const int q4 = (lane & 15) >> 2, pp = lane & 3, blk = (lane >> 4) & 1;
    int j = (MODE == 1) ? blist[0] : jfirst;
    u32x4 kreg = *(const u32x4*)(Kg + (size_t)j * 4096 + ldoff), vreg = *(const u32x4*)(Vg + (size_t)j * 4096 + ldoff);
    for (int it = 0; it < nblk; ++it) {
        __syncthreads();
        *(LAS u32x4*)(Kl + stoff) = kreg; *(LAS u32x4*)(Vl + stoff) = vreg;
        __syncthreads();
        const int jc = j;
        if (it + 1 < nblk) { j = (MODE == 1) ? blist[it + 1] : jfirst + it + 1; kreg = *(const u32x4*)(Kg + (size_t)j * 4096 + ldoff); vreg = *(const u32x4*)(Vg + (size_t)j * 4096 + ldoff); }
        bool sel = true;
        if (MODE == 1) { const unsigned w = sel16[tl * 8 + (jc >> 4)]; sel = ((w >> (jc & 15)) & 1u) != 0u; if (!__any(sel)) continue; }
        bf16x8 kf[8];
#pragma unroll
        for (int s = 0; s < 4; ++s) { kf[2 * s] = *(const LAS bf16x8*)(Kl + r32 * 144 + (16 * s + 8 * hi) * 2); kf[2 * s + 1] = *(const LAS bf16x8*)(Kl + (32 + r32) * 144 + (16 * s + 8 * hi) * 2); }
        s16x4 vlo[8], vhi[8];
#pragma unroll
        for (int dblk = 0; dblk < 2; ++dblk)
#pragma unroll
            for (int ks = 0; ks < 4; ++ks) { const int rb = 32 * (ks >> 1) + 16 * (ks & 1) + 4 * hi + q4;
                LAS const unsigned char* vp = Vl + rb * 144 + (32 * dblk + 16 * blk) * 2 + 8 * pp;
                vlo[dblk * 4 + ks] = tr_rd(vp); vhi[dblk * 4 + ks] = tr_rd(vp + 8 * 144); }
        __builtin_amdgcn_sched_barrier(0);
        f32x16 p0 = MFMA32(kf[0], qr[0], negm), p1 = MFMA32(kf[1], qr[0], negm);
#pragma unroll
        for (int s = 1; s < 4; ++s) { p0 = MFMA32(kf[2 * s], qr[s], p0); p1 = MFMA32(kf[2 * s + 1], qr[s], p1); }
        if (MODE == 0) {
#pragma unroll
            for (int i = 0; i < 16; ++i) { const int c = 64 * jc + crow(i, hi); if (c > cmax) p0[i] = -1e30f; if (c + 32 > cmax) p1[i] = -1e30f; }
        } else {
            if (jc == cur) {
#pragma unroll
                for (int i = 0; i < 16; ++i) { const int kk = crow(i, hi); if (kk > tl) p0[i] = -1e30f; if (kk + 32 > tl) p1[i] = -1e30f; }
            } else if (MODE == 2 && jc == cur - 8) {
#pragma unroll
                for (int i = 0; i < 16; ++i) { const int kk = crow(i, hi); if (kk <= tl) p0[i] = -1e30f; if (kk + 32 <= tl) p1[i] = -1e30f; }
            }
        }
#pragma unroll
        for (int i = 0; i < 16; ++i) { p0[i] = __builtin_amdgcn_exp2f(p0[i]); p1[i] = __builtin_amdgcn_exp2f(p1[i]); }
        u32x4 pw[4];
        pw[0] = __builtin_bit_cast(u32x4, packp(p0, 0)); pw[1] = __builtin_bit_cast(u32x4, packp(p0, 1)); pw[2] = __builtin_bit_cast(u32x4, packp(p1, 0)); pw[3] = __builtin_bit_cast(u32x4, packp(p1, 1));
        if (MODE == 1) { const unsigned sm = sel ? 0xffffffffu : 0u;
#pragma unroll
            for (int k = 0; k < 4; ++k) { pw[k].x &= sm; pw[k].y &= sm; pw[k].z &= sm; pw[k].w &= sm; } }
#pragma unroll
        for (int ks = 0; ks < 4; ++ks)
#pragma unroll
            for (int dblk = 0; dblk < 2; ++dblk) { const bf16x8 vf = __builtin_shufflevector(vlo[dblk * 4 + ks], vhi[dblk * 4 + ks], 0, 1, 2, 3, 4, 5, 6, 7);
                o[dblk] = MFMA32(vf, __builtin_bit_cast(bf16x8, pw[ks]), o[dblk]); }
#pragma unroll
        for (int ks = 0; ks < 4; ++ks) lacc = MFMA32(ones, __builtin_bit_cast(bf16x8, pw[ks]), lacc);
    }
    const float l = lacc[0]; const bool bad = !(l < 1e15f);
    m_run = bad ? 1.f : 0.f; l_run = 0.5f * l;
}

DI void attn_unit(LAS unsigned char* lds, const AttnP& P, int b, int g, int qb) {
    int tid = threadIdx.x; asm volatile("" : "+v"(tid));
    const int lane = tid & 63, w = tid >> 6, r32 = lane & 31, hi = lane >> 5;
    const int tt = r32 & 7, h = r32 >> 3, tl = 8 * w + tt, t0 = qb * 64, t = t0 + tl, cur = qb;
    LAS float* imp = (LAS float*)(lds + AT_IMP); LAS unsigned short* sel16 = (LAS unsigned short*)(lds + AT_SEL); LAS int* blist = (LAS int*)(lds + AT_BLIST); LAS int* nl = (LAS int*)(lds + AT_NL);
    const size_t bg = (size_t)(b * 2 + g);
    const bf16_t* qp = P.Q + ((size_t)(b * 8 + 4 * g + h) * SEQ + t) * 64 + 8 * hi;
    bf16x8 qr[4];
#pragma unroll
    for (int s = 0; s < 4; ++s) qr[s] = *(const bf16x8*)(qp + 16 * s);
#define AT_GATE(k_) (P.gates[(size_t)(b * SEQ + t) * 24 + (4 * g + h) * 3 + (k_)])
    LAS unsigned* otp = (LAS unsigned*)(lds + AT_OTP) + tid; f32x16 o[2]; float m_run, l_run;
    __syncthreads();
    for (int i = tid; i < 64 * 128; i += 512) imp[i] = 0.f;
    const bf16_t* Kc = P.KCc + bg * 512 * 64; const bf16_t* Vc = P.VCc + bg * 512 * 64;
    const int ncb = (((t0 + 63 - 31) >> 4) >> 6) + 1;
    attn_branch_fast<0>(lds, Kc, Vc, ncb, 0, cur, qr, t, tl, m_run, l_run, o);
    if (__syncthreads_or(m_run != 0.f)) attn_branch<0>(lds, Kc, Vc, ncb, 0, cur, qr, t, tl, m_run, l_run, o);
    {
        const float lt = l_run + __shfl_xor(l_run, 32); const float inv = lt > 0.f ? 1.f / lt : 0.f; const float sc = AT_GATE(0) * inv;
#pragma unroll
        for (int i = 0; i < 8; ++i) { otp[i * 512] = cvtpk(o[0][2 * i] * sc, o[0][2 * i + 1] * sc); otp[(8 + i) * 512] = cvtpk(o[1][2 * i] * sc, o[1][2 * i + 1] * sc); }
        const float m_sub = m_run; f32x16 zc;
#pragma unroll
        for (int i = 0; i < 16; ++i) zc[i] = 0.f;
        const int cmax = (t >= 31) ? ((t - 31) >> 4) : -1;
        bf16x8 ovf[4];
#pragma unroll
        for (int ks = 0; ks < 4; ++ks)
#pragma unroll
            for (int jj = 0; jj < 8; ++jj) { const int key = 32 * (ks >> 1) + 16 * (ks & 1) + 8 * (jj >> 2) + 4 * hi + (jj & 3); ovf[ks][jj] = (4 * r32 - 1 <= key && key <= 4 * r32 + 3) ? (short)0x3F80 : (short)0; }
        LAS unsigned char* Kl = lds + AT_KL; const int ldoff = tid * 8, stoff = (tid >> 3) * 144 + (tid & 7) * 16;
        u32x4 kreg = *(const u32x4*)(Kc + ldoff);
        for (int it = 0; it < ncb; ++it) {
            __syncthreads();
            *(LAS u32x4*)(Kl + stoff) = kreg;
            __syncthreads();
            if (it + 1 < ncb) kreg = *(const u32x4*)(Kc + (size_t)(it + 1) * 4096 + ldoff);
            f32x16 p0, p1; qk_tile(Kl, qr, zc, r32, hi, p0, p1);
#pragma unroll
            for (int i = 0; i < 16; ++i) { const int c = 64 * it + crow(i, hi);
                p0[i] = (c <= cmax) ? __builtin_amdgcn_exp2f(p0[i] - m_sub) * inv : 0.f; p1[i] = (c + 32 <= cmax) ? __builtin_amdgcn_exp2f(p1[i] - m_sub) * inv : 0.f; }
            bf16x8 pf[4]; pf[0] = packp(p0, 0); pf[1] = packp(p0, 1); pf[2] = packp(p1, 0); pf[3] = packp(p1, 1);
            f32x16 it_;
#pragma unroll
            for (int i = 0; i < 16; ++i) it_[i] = 0.f;
#pragma unroll
            for (int ks = 0; ks < 4; ++ks) it_ = MFMA32(ovf[ks], pf[ks], it_);
#pragma unroll
            for (int i = 0; i < 9; ++i) { float v = it_[i]; v += __shfl_xor(v, 8); v += __shfl_xor(v, 16);
                const int srel = crow(i, hi), s = 16 * it + srel;
                if (h == 0 && srel <= 16 && s < 128) imp[tl * 128 + s] += v; }
        }
    }
    __syncthreads();
    {
        const int tt2 = tid >> 3, part = tid & 7, s0 = 16 * part; unsigned bits = 0;
        if (cur < 16) { for (int k = 0; k < 16; ++k) if (s0 + k <= cur) bits |= 1u << k; }
        else {
            unsigned u[16]; unsigned cm = 0u;
#pragma unroll
            for (int k = 0; k < 16; ++k) { const int s = s0 + k; const bool cand = (s >= 1 && s <= cur - 2); u[k] = cand ? __float_as_uint(imp[tt2 * 128 + s]) : 0u; cm |= cand ? (1u << k) : 0u; }
            unsigned T = 0u;
            for (int bit = 30; bit >= 0; --bit) { const unsigned cd = T | (1u << bit); int c = 0;
#pragma unroll
                for (int k = 0; k < 16; ++k) c += (u[k] >= cd) ? 1 : 0;
                c += __shfl_xor(c, 1); c += __shfl_xor(c, 2); c += __shfl_xor(c, 4);
                if (c >= 13) T = cd; }
            unsigned gtm = 0u, eqm = 0u;
#pragma unroll
            for (int k = 0; k < 16; ++k) { gtm |= (u[k] > T) ? (1u << k) : 0u; eqm |= (u[k] == T) ? (1u << k) : 0u; }
            eqm &= cm; gtm &= cm;
            int cgt = __popc(gtm); cgt += __shfl_xor(cgt, 1); cgt += __shfl_xor(cgt, 2); cgt += __shfl_xor(cgt, 4);
            const int ceq = __popc(eqm); int pre = 0;
#pragma unroll
            for (int q = 0; q < 8; ++q) { const int cq = __shfl(ceq, (lane & ~7) | q); pre += (q < part) ? cq : 0; }
            int quota = 13 - cgt - pre; unsigned selq = 0u;
#pragma unroll
            for (int k = 0; k < 16; ++k) if ((eqm >> k) & 1u) { if (quota > 0) { selq |= 1u << k; --quota; } }
            bits = gtm | selq;
#pragma unroll
            for (int k = 0; k < 16; ++k) { const int s = s0 + k; if (s == 0 || s == cur || s == cur - 1) bits |= 1u << k; }
        }
        sel16[tt2 * 8 + part] = (unsigned short)bits;
    }
    __syncthreads();
    if (w == 0) {
        int base = 0;
        for (int half = 0; half < 2; ++half) { const int s = 64 * half + lane; unsigned any = 0;
            for (int q = 0; q < 64; ++q) any |= sel16[q * 8 + (s >> 4)];
            const bool need = ((any >> (s & 15)) & 1u) && s <= cur;
            const unsigned long long bm = __ballot(need);
            if (need) blist[base + __popcll(bm & ((1ull << lane) - 1ull))] = s;
            base += __popcll(bm); }
        if (lane == 0) nl[0] = base;
    }
    __syncthreads();
    {
        const int nsl = nl[0];
        attn_branch_fast<1>(lds, P.KS + bg * SEQ * 64, P.VS + bg * SEQ * 64, nsl, 0, cur, qr, t, tl, m_run, l_run, o);
    if (__syncthreads_or(m_run != 0.f)) attn_branch<1>(lds, P.KS + bg * SEQ * 64, P.VS + bg * SEQ * 64, nsl, 0, cur, qr, t, tl, m_run, l_run, o);
        const float lt = l_run + __shfl_xor(l_run, 32); const float sc = AT_GATE(1) * (lt > 0.f ? 1.f / lt : 0.f);
#pragma unroll
        for (int i = 0; i < 8; ++i) { const unsigned a_ = otp[i * 512], b_ = otp[(8 + i) * 512]; otp[i * 512] = cvtpk(__uint_as_float(a_ << 16) + o[0][2 * i] * sc, __uint_as_float(a_ & 0xffff0000u) + o[0][2 * i + 1] * sc);
            otp[(8 + i) * 512] = cvtpk(__uint_as_float(b_ << 16) + o[1][2 * i] * sc, __uint_as_float(b_ & 0xffff0000u) + o[1][2 * i + 1] * sc); }
    }
    {
        const int jf = cur >= 8 ? cur - 8 : 0;
        attn_branch_fast<2>(lds, P.KW + bg * SEQ * 64, P.VW + bg * SEQ * 64, cur - jf + 1, jf, cur, qr, t, tl, m_run, l_run, o);
    if (__syncthreads_or(m_run != 0.f)) attn_branch<2>(lds, P.KW + bg * SEQ * 64, P.VW + bg * SEQ * 64, cur - jf + 1, jf, cur, qr, t, tl, m_run, l_run, o);
        const float lt = l_run + __shfl_xor(l_run, 32); const float sc = AT_GATE(2) * (lt > 0.f ? 1.f / lt : 0.f);
#pragma unroll
        for (int i = 0; i < 8; ++i) { const unsigned a_ = otp[i * 512], b_ = otp[(8 + i) * 512]; otp[i * 512] = cvtpk(__uint_as_float(a_ << 16) + o[0][2 * i] * sc, __uint_as_float(a_ & 0xffff0000u) + o[0][2 * i + 1] * sc);
            otp[(8 + i) * 512] = cvtpk(__uint_as_float(b_ << 16) + o[1][2 * i] * sc, __uint_as_float(b_ & 0xffff0000u) + o[1][2 * i + 1] * sc); }
    }
    bf16_t* op = P.Oc + (size_t)(b * SEQ + t) * DM + (4 * g + h) * 64 + 4 * hi;
#pragma unroll
    for (int dblk = 0; dblk < 2; ++dblk)
#pragma unroll
        for (int ig = 0; ig < 4; ++ig) { u32x2 v; v.x = otp[(8 * dblk + 2 * ig) * 512]; v.y = otp[(8 * dblk + 2 * ig + 1) * 512];
            *(u32x2*)(op + 32 * dblk + 8 * ig) = v; }
}


#define XB_TMO      128
#define XB_XCNT(j)  (256  + 64 * (j))
#define XB_XSUB(j)  (1280 + 64 * (j))
#define XB_XGEN(j)  (2304 + 64 * (j))
#define XB_TOP      3328
#define XB_TOPGEN   3392
#define XCD_BAR_WORDS 3456
#define XB_SPIN_CAP (1u << 22)
DI unsigned xb_ld(unsigned* p)              { return __hip_atomic_load(p, __ATOMIC_RELAXED, __HIP_MEMORY_SCOPE_AGENT); }
DI unsigned xb_add(unsigned* p, unsigned v) { return __hip_atomic_fetch_add(p, v, __ATOMIC_RELAXED, __HIP_MEMORY_SCOPE_AGENT); }
DI unsigned xb_xcc_id() { return (unsigned)__builtin_amdgcn_s_getreg((3 << 11) | 20) & 0xFu; }
#define XB_SPIN(cond, bar) do { unsigned _sp = 0; while (cond) { __builtin_amdgcn_s_sleep(1); \
    if ((++_sp & 255u) == 0u) { if (xb_ld(&(bar)[XB_TMO])) break; if (_sp > XB_SPIN_CAP) { atomicAdd(&(bar)[XB_TMO], 1u); break; } } } } while (0)
struct XcdBarrier { unsigned* bar; unsigned x; volatile LAS unsigned* st; };
DI XcdBarrier xcd_barrier_post(unsigned* bar, volatile LAS unsigned* st) {
    XcdBarrier b; b.bar = bar; b.x = xb_xcc_id(); b.st = st;
    if (threadIdx.x == 0) (void)xb_add(&bar[XB_XCNT(b.x)], 1u);
    return b;
}
DI void xcd_barrier_complete(unsigned* bar, unsigned x, unsigned& nloc, unsigned& nx) {
    const unsigned G = gridDim.x * gridDim.y * gridDim.z;
    unsigned sum, cnt, mine, sp = 0u;
    for (;;) {
        sum = 0u; cnt = 0u; mine = 0u;
#pragma unroll
        for (unsigned j = 0; j < 16; ++j) { const unsigned c = xb_ld(&bar[XB_XCNT(j)]); sum += c; cnt += (c > 0u) ? 1u : 0u; mine = (j == x) ? c : mine; }
        if (sum == G) break;
        __builtin_amdgcn_s_sleep(1);
        if ((++sp & 255u) == 0u) { if (xb_ld(&bar[XB_TMO])) break; if (sp > XB_SPIN_CAP) { atomicAdd(&bar[XB_TMO], 1u); break; } }
    }
    nloc = mine > 0u ? mine : 1u; nx = cnt > 0u ? cnt : 1u;
}
DI void xcd_barrier(const XcdBarrier& b) {
    asm volatile("s_waitcnt vmcnt(0)" ::: "memory");
    __syncthreads();
    if (threadIdx.x == 0) {
        unsigned* bar = b.bar;
        __builtin_amdgcn_s_waitcnt(0);
        unsigned nloc = b.st[0], nx = b.st[1];
        if (nloc == 0u) { xcd_barrier_complete(bar, b.x, nloc, nx); b.st[0] = nloc; b.st[1] = nx; }
        const unsigned old = xb_add(&bar[XB_XSUB(b.x)], 1u);
        const unsigned gen = old / nloc;
        if (old + 1u == (gen + 1u) * nloc) {
            __builtin_amdgcn_fence(__ATOMIC_RELEASE, "agent");
            asm volatile("s_waitcnt vmcnt(0)" ::: "memory");
            const unsigned og = xb_add(&bar[XB_TOP], 1u);
            const unsigned tg = og / nx;
            if (og + 1u == (tg + 1u) * nx) xb_add(&bar[XB_TOPGEN], 1u);
            else XB_SPIN(xb_ld(&bar[XB_TOPGEN]) == tg, bar);
            __builtin_amdgcn_fence(__ATOMIC_ACQUIRE, "agent");
            xb_add(&bar[XB_XGEN(b.x)], 1u);
            asm volatile("s_waitcnt vmcnt(0)" ::: "memory");
        } else {
            XB_SPIN(xb_ld(&bar[XB_XGEN(b.x)]) == gen, bar);
            __builtin_amdgcn_fence(__ATOMIC_ACQUIRE, "agent");
            asm volatile("s_waitcnt vmcnt(0)" ::: "memory");
        }
    }
    __syncthreads();
}

#ifndef REP_P0
#define REP_P0 1
#endif
#ifndef REP_P1
#define REP_P1 1
#endif
#ifndef REP_P2
#define REP_P2 1
#endif
#ifndef REP_P3
#define REP_P3 1
#endif
#ifndef REP_P4
#define REP_P4 1
#endif
#ifndef REP_P5
#define REP_P5 1
#endif
#ifndef REP_P6
#define REP_P6 1
#endif
#ifndef REP_P7
#define REP_P7 1
#endif
#ifndef REP_P8
#define REP_P8 1
#endif
#ifndef REP_P9
#define REP_P9 1
#endif
#ifndef REP_P10
#define REP_P10 1
#endif
#ifndef REP_P11
#define REP_P11 1
#endif
#ifndef REP_P12
#define REP_P12 1
#endif
constexpr int NTHR = 512;
constexpr int LDS_BYTES = 147456;

__global__ void __launch_bounds__(NTHR, 2) mega_fwd(KP kp) {
    extern __shared__ __attribute__((aligned(16))) unsigned char lds_raw[];
    LAS unsigned char* lds = (LAS unsigned char*)lds_raw;
    cg::grid_group grid = cg::this_grid();
    const int G = gridDim.x, bid = blockIdx.x, NGW = G * 8;
    volatile LAS unsigned* MISC = (volatile LAS unsigned*)(lds + 143360);
    if (threadIdx.x < 2) MISC[threadIdx.x] = 0u;
    __syncthreads();
    const XcdBarrier xbar = xcd_barrier_post((unsigned*)kp.ws, MISC);
    if (kp.out == nullptr) grid.sync();
    const float* x = kp.in[0]; const float* pin = kp.in[1];
    float* out = kp.out;
#define PH_BEGIN int tid = threadIdx.x; asm volatile("" : "+v"(tid)); const int lane = tid & 63, wave = __builtin_amdgcn_readfirstlane(tid >> 6), gw = bid * 8 + wave; unsigned char* ws = kp.ws; asm volatile("" : "+s"(ws)); (void)lane; (void)gw;
#define COS ((float*)(ws + WS_COS))
#define SIN ((float*)(ws + WS_SIN))
#define SS ((float*)(ws + WS_SS))
#define KR ((float*)(ws + WS_KR))
#define SS2 ((float*)(ws + WS_SS2))
#define A64 ((float*)(ws + WS_A64))
#define BIASP ((float*)(ws + WS_BIASP))
#define BIAS ((float*)(ws + WS_BIAS))
#define W13A ((bf16_t*)(ws + WS_W13A))
#define W2A ((bf16_t*)(ws + WS_W2A))
#define W13B ((bf16_t*)(ws + WS_W13B))
#define W2B ((bf16_t*)(ws + WS_W2B))
#define WIN ((bf16_t*)(ws + WS_WIN))
#define WOUT ((bf16_t*)(ws + WS_WOUT))
#define WG ((bf16_t*)(ws + WS_WG))
#define WPLE ((bf16_t*)(ws + WS_WPLE))
#define WGLU ((bf16_t*)(ws + WS_WGLU))
#define WK1 ((bf16_t*)(ws + WS_WK1))
#define WV1 ((bf16_t*)(ws + WS_WV1))
#define WK2 ((bf16_t*)(ws + WS_WK2))
#define WV2 ((bf16_t*)(ws + WS_WV2))
#define PB ((bf16_t*)(ws + WS_PB))
#define HB ((bf16_t*)(ws + WS_HB))
#define OC ((bf16_t*)(ws + WS_OC))
#define TTB ((bf16_t*)(ws + WS_TT))
#define PT ((bf16_t*)(ws + WS_PT))
#define EB ((bf16_t*)(ws + WS_E))
#define ACT ((bf16_t*)(ws + WS_ACT))
#define QB ((bf16_t*)(ws + WS_Q))
#define KC ((bf16_t*)(ws + WS_KC))
#define VC ((bf16_t*)(ws + WS_VC))
#define KS ((bf16_t*)(ws + WS_KS))
#define VS ((bf16_t*)(ws + WS_VS))
#define KW ((bf16_t*)(ws + WS_KW))
#define VW ((bf16_t*)(ws + WS_VW))
#define AEXT ((bf16_t*)(ws + WS_AEXT))
#define HC ((bf16_t*)(ws + WS_HC))
#define KCMP ((bf16_t*)(ws + WS_KCMP))
#define VCMP ((bf16_t*)(ws + WS_VCMP))
#define YP ((bf16_t*)(ws + WS_YP))
#define GATES ((float*)(ws + WS_GATES))
#define SLOC ((float*)(ws + WS_SLOC))

    for (int rep_ = 0; rep_ < REP_P0; ++rep_) {
        PH_BEGIN
        LAS float* scr = (LAS float*)(lds + wave * 16384);
        int itbase = 0;
#define TJOB(kind, W, W3, Nsrc, K, Np, sc, Bt) do { const int ni = ((K) / 64) * ((Np) / 32); int first = (gw - itbase) % NGW; if (first < 0) first += NGW; \
            for (int it = first; it < ni; it += NGW) transpose_item(kind, W, W3, Nsrc, K, Np, sc, Bt, scr, it, lane); itbase += ni; } while (0)
        TJOB(1, kp.in[3], kp.in[4], DFF, DM, 5632, kp.in[2], W13A);
        TJOB(0, kp.in[5], nullptr, DM, DFF, DM, nullptr, W2A);
        TJOB(1, kp.in[26], kp.in[27], DFF, DM, 5632, kp.in[25], W13B);
        TJOB(0, kp.in[28], nullptr, DM, DFF, DM, nullptr, W2B);
        TJOB(2, kp.in[7], nullptr, 1816, DM, 2048, kp.in[6], WIN);
        TJOB(0, kp.in[24], nullptr, DM, DM, DM, nullptr, WOUT);
        TJOB(0, kp.in[30], nullptr, DM, DM, DM, kp.in[29], WG);
        TJOB(0, kp.in[31], nullptr, DM, 256, DM, nullptr, WPLE);
        TJOB(0, kp.in[22], nullptr, 512, 512, 512, nullptr, WGLU);
        TJOB(0, kp.in[10], nullptr, 256, 2048, 256, nullptr, WK1);
        TJOB(0, kp.in[12], nullptr, 256, 2048, 256, nullptr, WV1);
        TJOB(0, kp.in[11], nullptr, 64, 256, 64, nullptr, WK2);
        TJOB(0, kp.in[13], nullptr, 64, 256, 64, nullptr, WV2);
#undef TJOB
        for (int m = gw; m < TT; m += NGW) { const f32x4* xr = (const f32x4*)(x + (size_t)m * DM) + lane; unsigned long long* o8 = (unsigned long long*)(HB + (size_t)m * DM) + lane; float s = 0.f;
#pragma unroll
            for (int j = 0; j < 4; ++j) { const f32x4 v = __builtin_nontemporal_load(xr + 64 * j); s += (v[0] * v[0] + v[1] * v[1]) + (v[2] * v[2] + v[3] * v[3]); o8[64 * j] = (unsigned long long)cvtpk(v[0], v[1]) | ((unsigned long long)cvtpk(v[2], v[3]) << 32); }
            s = wave_sum(s);
            if (lane < 16) SS[(size_t)lane * TT + m] = (lane == 0) ? s : 0.f; }
        for (size_t i = (size_t)bid * NTHR + tid; i < (size_t)TT * 256 / 8; i += (size_t)G * NTHR) { const f32x4 a = __builtin_nontemporal_load((const f32x4*)(pin + i * 8)), b2 = __builtin_nontemporal_load((const f32x4*)(pin + i * 8 + 4)); *(u32x4*)(PB + i * 8) = pack8(a, b2); }
        for (int i = bid * NTHR + tid; i < 32; i += G * NTHR) { const float inv = (float)exp2(-(double)i / 32.0 * 13.287712379549449); COS[i] = (float)((double)inv * 0.15915494309189535); }
        for (int it = gw; it < 512; it += NGW) { const int kv = it >> 8, sl = it & 255; const float* pe = kp.in[8 + kv] + sl * 8; const float* w1 = kp.in[kv ? 12 : 10] + (size_t)(sl * 8) * 256; float a4[4] = {0.f, 0.f, 0.f, 0.f};
            float wv[8][4], pv[8];
#pragma unroll
            for (int k = 0; k < 8; ++k) { pv[k] = pe[k];
#pragma unroll
                for (int c = 0; c < 4; ++c) wv[k][c] = w1[k * 256 + lane + 64 * c]; }
#pragma unroll
            for (int k = 0; k < 8; ++k)
#pragma unroll
                for (int c = 0; c < 4; ++c) a4[c] += pv[k] * wv[k][c];
#pragma unroll
            for (int c = 0; c < 4; ++c) BIASP[(size_t)it * 256 + lane + 64 * c] = a4[c]; }
        {
            __syncthreads();
            LAS float* bre = (LAS float*)lds; LAS float* bim = bre + 1024; LAS float* cre = bim + 1024; LAS float* cim = cre + 1024;
            LAS float* W1r = cim + 1024; LAS float* W1i = W1r + 512; LAS float* W2r = W1i + 512; LAS float* W2i = W2r + 512;
            const float *a_re = kp.in[14], *a_im = kp.in[15], *log_dt = kp.in[16], *b_re = kp.in[17], *b_im = kp.in[18], *c_re = kp.in[19], *c_im = kp.in[20], *dsk = kp.in[21];
            for (int it = bid; it < 256; it += G) { const int g = it >> 3, j0 = (it & 7) * 8;
                __syncthreads();
                for (int idx = tid; idx < 1024; idx += NTHR) { bre[idx] = b_re[g * 1024 + idx]; bim[idx] = b_im[g * 1024 + idx]; cre[idx] = c_re[g * 1024 + idx]; cim[idx] = c_im[g * 1024 + idx]; }
                { const int jj = tid >> 6, n = tid & 63, j = j0 + jj; const double are = a_re[g * 64 + n], aim = a_im[g * 64 + n], dt = exp((double)log_dt[g]);
                    const double zr = are * dt, zi = aim * dt; double sn_, cs_; sincos_d(zi, sn_, cs_); const double ea = exp(zr), abr = ea * cs_, abi = ea * sn_;
                    const double nr = abr - 1.0, ni = abi, den = are * are + aim * aim, bcr = (nr * are + ni * aim) / den, bci = (ni * are - nr * aim) / den;
                    double sj, cj; sincos_d(zi * j, sj, cj); const double ej = exp(zr * j), er = ej * cj, ei = ej * sj;
                    W1r[tid] = (float)(er * bcr - ei * bci); W1i[tid] = (float)(er * bci + ei * bcr);
                    W2r[tid] = (float)(er * abr - ei * abi); W2i[tid] = (float)(er * abi + ei * abr);
                    if (j == 0) { double s6, c6; sincos_d(zi * 64.0, s6, c6); const double e6 = exp(zr * 64.0); A64[(g * 64 + n) * 2] = (float)(e6 * c6); A64[(g * 64 + n) * 2 + 1] = (float)(e6 * s6); } }
                __syncthreads();
#pragma unroll 1
                for (int q = 0; q < 4; ++q) { const int idx = tid + NTHR * q, jj = idx >> 8, o = (idx >> 4) & 15, i = idx & 15; float s = 0.f;
#pragma unroll 8
                    for (int n = 0; n < 64; ++n) { const float cr = cre[o * 64 + n], ci = cim[o * 64 + n], w1r = W1r[jj * 64 + n], w1i = W1i[jj * 64 + n];
                        s += (cr * w1r - ci * w1i) * bre[n * 16 + i] - (cr * w1i + ci * w1r) * bim[n * 16 + i]; }
                    if (j0 + jj == 0 && o == i) s += dsk[g * 16 + o];
                    KR[((size_t)(g * 64 + j0 + jj)) * 256 + (idx & 255)] = s; }
#pragma unroll 4
                for (int q = 0; q < 16; ++q) { const int idx = tid + NTHR * q, jj = idx >> 10, o = (idx >> 6) & 15, n = idx & 63;
                    const float cr = cre[o * 64 + n], ci = cim[o * 64 + n], w2r = W2r[jj * 64 + n], w2i = W2i[jj * 64 + n];
                    const unsigned pr = cvtpk(cr * w2r - ci * w2i, -(cr * w2i + ci * w2r));
                    bf16_t* trow = TTB + ((size_t)(g * 1024 + (j0 + jj) * 16 + o)) * 1152; trow[n] = (bf16_t)(pr & 0xffffu); trow[64 + n] = (bf16_t)(pr >> 16); }
#pragma unroll 4
                for (int q = 0; q < 16; ++q) { const int idx = tid + NTHR * q, jj = idx >> 10, n = (idx >> 4) & 63, i = idx & 15;
                    const float br = bre[n * 16 + i], bi = bim[n * 16 + i], w1r = W1r[jj * 64 + n], w1i = W1i[jj * 64 + n];
                    const unsigned pr = cvtpk(w1r * br - w1i * bi, w1r * bi + w1i * br); const int sI = 63 - (j0 + jj);
                    PT[((size_t)(g * 128 + n)) * 1024 + sI * 16 + i] = (bf16_t)(pr & 0xffffu); PT[((size_t)(g * 128 + 64 + n)) * 1024 + sI * 16 + i] = (bf16_t)(pr >> 16); }
            }
            __syncthreads();
        }
    }
    xcd_barrier(xbar);
    for (int rep_ = 0; rep_ < REP_P1; ++rep_) {
        PH_BEGIN
        for (int o_ = gw; o_ < 512; o_ += NGW) { float s_ = 0.f;
#pragma unroll
            for (int q = 0; q < 4; ++q) s_ += BIASP[((size_t)(o_ >> 8) * 256 + lane + 64 * q) * 256 + (o_ & 255)];
            s_ = wave_sum(s_); if (lane == 0) BIAS[o_] = s_; }
        pg8::Gemm g{HB, W13A, DM, DM, DM}; pg8::SchedGrid S; S.init(TT, 5632, G, bid); EpiSwiGLU E{ACT, SS, lds}; if (tid == 0) *(volatile LAS int*)(lds + 131072 + 1024) = -1; __syncthreads();
        pg8::gemm_phase<EpiSwiGLU, pg8::SchedGrid, true>(lds, g, S, E);
    }
    xcd_barrier(xbar);
    for (int rep_ = 0; rep_ < REP_P2; ++rep_) {
        PH_BEGIN
        pg8::Gemm g{ACT, W2A, DFF, 64, DFF, (size_t)TT * 128}; pg8::SchedGrid S; S.init(TT, DM, G, bid); EpiResid<false> E{nullptr, HB, SS, 0.5f};
        pg8::gemm_phase<EpiResid<false>, pg8::SchedGrid, true>(lds, g, S, E);
    }
    xcd_barrier(xbar);
    for (int rep_ = 0; rep_ < REP_P3; ++rep_) {
        PH_BEGIN
        pg8::Gemm g{HB, WIN, DM, DM, DM}; pg8::SchedGrid S; S.init(TT, 2048, G, bid); EpiWin E{SS, COS, SIN, QB, KC, VC, KS, VS, KW, VW, GATES, AEXT};
        pg8::gemm_phase<EpiWin, pg8::SchedGrid, true>(lds, g, S, E);
    }
    xcd_barrier(xbar);
    for (int rep_ = 0; rep_ < REP_P4; ++rep_) {
        PH_BEGIN
        { const int tn_ = (G > 128) ? G - 96 : G, tb_ = (G > 128) ? bid - 96 : bid;
          if (tb_ >= 0) {
#pragma unroll 4
        for (size_t i = (size_t)tb_ * NTHR + tid; i < (size_t)32 * 1024 * 128; i += (size_t)tn_ * NTHR) { const int ch = (int)(i & 127), rown = (int)(i >> 7), g = rown >> 10, t = (rown >> 4) & 63, o = rown & 15, s = ch >> 1, i0 = (ch & 1) * 8;
            u32x4 v = (u32x4){0u, 0u, 0u, 0u};
            if (s <= t) { const float* kr = KR + ((size_t)(g * 64 + (t - s))) * 256 + o * 16 + i0; v = pack8(*(const f32x4*)kr, *(const f32x4*)(kr + 4)); }
            if (s < 16 * ((t >> 4) + 1)) *(u32x4*)(TTB + (size_t)rown * 1152 + 128 + ch * 8) = v; }
          } }
        { pg8::Gemm g{KC, WK1, 2048, 1024, 2048}; pg8::SchedGrid S; S.init(4096, 256, G, bid); EpiCmp1 E{HC, BIAS}; pg8::gemm_phase<EpiCmp1, pg8::SchedGrid, true>(lds, g, S, E); }
        { pg8::Gemm g{VC, WV1, 2048, 1024, 2048}; pg8::SchedGrid S; S.init(4096, 256, G, (bid + G - 16) % G); EpiCmp1 E{HC + (size_t)4096 * 256, BIAS + 256}; pg8::gemm_phase<EpiCmp1, pg8::SchedGrid, true>(lds, g, S, E); }
        { pg8::Gemm g{AEXT + 128, PT, 1024, 1152, 1024}; pg8::SchedBatch S{32, 2, 1, 512, 128, G, (bid + G - 32) % G}; EpiSloc E{SLOC}; pg8::gemm_phase<EpiSloc, pg8::SchedBatch, true>(lds, g, S, E); }
    }
    xcd_barrier(xbar);
    for (int rep_ = 0; rep_ < REP_P5; ++rep_) {
        PH_BEGIN
        for (int it = gw; it < 256; it += NGW) { const int r32 = lane & 31, hi = lane >> 5, rowb = it * 32, kv = rowb >> 12; const bf16_t* W2t = kv ? WV2 : WK2;
            f32x16 a0, a1;
#pragma unroll
            for (int i = 0; i < 16; ++i) { a0[i] = 0.f; a1[i] = 0.f; }
#pragma unroll
            for (int s = 0; s < 16; ++s) { const bf16x8 af = *(const bf16x8*)(HC + (size_t)(rowb + r32) * 256 + 16 * s + 8 * hi);
                const bf16x8 b0 = *(const bf16x8*)(W2t + (size_t)r32 * 256 + 16 * s + 8 * hi), b1 = *(const bf16x8*)(W2t + (size_t)(32 + r32) * 256 + 16 * s + 8 * hi);
                a0 = MFMA32(af, b0, a0); a1 = MFMA32(af, b1, a1); }
            bf16_t* dst = kv ? VCMP : KCMP;
#pragma unroll
            for (int i = 0; i < 16; ++i) { const int R = (rowb & 4095) + crow(i, hi), c = R & 511; const unsigned pk = cvtpk(c == 511 ? 0.f : a0[i], c == 511 ? 0.f : a1[i]);
                dst[(size_t)R * 64 + r32] = (bf16_t)(pk & 0xffffu); dst[(size_t)R * 64 + 32 + r32] = (bf16_t)(pk >> 16); } }
        if (tid < 64 && bid < 128) { const int idx = bid * 64 + tid, gb = idx >> 6, n = idx & 63, g = gb >> 2, b = gb & 3;
            const float ar = A64[(g * 64 + n) * 2], ai = A64[(g * 64 + n) * 2 + 1]; float sr = 0.f, si = 0.f;
            const size_t row0 = (size_t)g * 512 + b * 128;
            for (int k0 = 0; k0 < 128; k0 += 8) { float lr[8], li[8];
#pragma unroll
                for (int q = 0; q < 8; ++q) { lr[q] = SLOC[(row0 + k0 + q) * 128 + n]; li[q] = SLOC[(row0 + k0 + q) * 128 + 64 + n]; }
#pragma unroll
                for (int q = 0; q < 8; ++q) { const unsigned pk = cvtpk(sr, si); bf16_t* ap = AEXT + (row0 + k0 + q) * 1152; ap[n] = (bf16_t)(pk & 0xffffu); ap[64 + n] = (bf16_t)(pk >> 16);
                    const float nr = ar * sr - ai * si + lr[q], ni = ar * si + ai * sr + li[q]; sr = nr; si = ni; } } }
    }
    xcd_barrier(xbar);
    for (int rep_ = 0; rep_ < REP_P6; ++rep_) {
        PH_BEGIN
        { pg8::Gemm g{AEXT, TTB, 1152, 1152, 1152}; pg8::SchedBatch S{32, 2, 4, 512, 1024, G, bid, 1}; EpiS5Y E{YP}; pg8::gemm_phase<EpiS5Y, pg8::SchedBatch, true>(lds, g, S, E); }
        const AttnP AP{QB, KS, VS, KW, VW, KCMP, VCMP, GATES, OC};
        if (G == 256) { const int bg = bid >> 5, s = bid & 31;
            for (int i = 0; i < 4; ++i) { const int qb = (i == 0) ? 127 - s : (i == 1) ? 64 + s : (i == 2) ? 63 - s : s; attn_unit(lds, AP, bg >> 1, bg & 1, qb); } }
        else { for (int L = bid; L < 1024; L += G) attn_unit(lds, AP, (L & 7) >> 1, L & 1, 127 - (L >> 3)); }
        __syncthreads();
    }
    xcd_barrier(xbar);
    for (int rep_ = 0; rep_ < REP_P7; ++rep_) {
        PH_BEGIN
        { pg8::Gemm g{YP, WGLU, 512, 512, 512}; pg8::SchedGrid S; S.init(TT, 512, G, bid); EpiGLU E{YP, kp.in[23], OC}; pg8::gemm_phase<EpiGLU, pg8::SchedGrid, true>(lds, g, S, E); }
        { pg8::Gemm g{PB, WPLE, 256, 256, 256}; pg8::SchedGrid S; S.init(TT, DM, G, bid); EpiStoreBf16 E{EB, DM}; pg8::gemm_phase<EpiStoreBf16, pg8::SchedGrid, true>(lds, g, S, E); }
    }
    xcd_barrier(xbar);
    for (int rep_ = 0; rep_ < REP_P8; ++rep_) {
        PH_BEGIN
        pg8::Gemm g{OC, WOUT, DM, DM, DM}; pg8::SchedGrid S; S.init(TT, DM, G, bid); EpiResid<false> E{nullptr, HB, SS, 1.0f};
        pg8::gemm_phase<EpiResid<false>, pg8::SchedGrid, true>(lds, g, S, E);
    }
    xcd_barrier(xbar);
    for (int rep_ = 0; rep_ < REP_P9; ++rep_) {
        PH_BEGIN
        pg8::Gemm g{HB, W13B, DM, DM, DM}; pg8::SchedGrid S; S.init(TT, 5632, G, bid); EpiSwiGLU E{ACT, SS, lds}; if (tid == 0) *(volatile LAS int*)(lds + 131072 + 1024) = -1; __syncthreads();
        pg8::gemm_phase<EpiSwiGLU, pg8::SchedGrid, true>(lds, g, S, E);
    }
    xcd_barrier(xbar);
    for (int rep_ = 0; rep_ < REP_P10; ++rep_) {
        PH_BEGIN
        pg8::Gemm g{ACT, W2B, DFF, 64, DFF, (size_t)TT * 128}; pg8::SchedGrid S; S.init(TT, DM, G, bid); EpiResid<false> E{nullptr, HB, SS, 0.5f};
        pg8::gemm_phase<EpiResid<false>, pg8::SchedGrid, true>(lds, g, S, E);
    }
    xcd_barrier(xbar);
    if (G == 256) {
        PH_BEGIN
        pg8::Gemm g{HB, WG, DM, DM, DM}; pg8::SchedGrid S; S.init(TT, DM, G, bid); EpiGateNorm E{SS, EB, HB, out, kp.in[32], SS2, (unsigned*)(ws + 16384), lds};
        pg8::gemm_phase<EpiGateNorm, pg8::SchedGrid, true>(lds, g, S, E);
        return;
    }
    for (int rep_ = 0; rep_ < REP_P11; ++rep_) {
        PH_BEGIN
        pg8::Gemm g{HB, WG, DM, DM, DM}; pg8::SchedGrid S; S.init(TT, DM, G, bid); EpiGate E{SS, EB, HB, OC, SS2};
        pg8::gemm_phase<EpiGate, pg8::SchedGrid, true>(lds, g, S, E);
    }
    xcd_barrier(xbar);
    for (int rep_ = 0; rep_ < REP_P12; ++rep_) {
        PH_BEGIN
        const float* gf = kp.in[32];
        for (int m = gw; m < TT; m += NGW) { float sp = (lane < 16) ? SS2[(size_t)lane * TT + m] : 0.f; sp = wave_sum(sp);
            const float r = rsqrtf(sp * (1.f / 1024.f) + RMS_EPS);
            const u32x2* hr = (const u32x2*)(OC + (size_t)m * DM) + lane; f32x4* orow = (f32x4*)(out + (size_t)m * DM) + lane;
#pragma unroll
            for (int j = 0; j < 4; ++j) { const u32x2 w = hr[64 * j]; const f32x4 gg = *((const f32x4*)gf + lane + 64 * j); f32x4 v;
                v[0] = __uint_as_float(w.x << 16); v[1] = __uint_as_float(w.x & 0xffff0000u); v[2] = __uint_as_float(w.y << 16); v[3] = __uint_as_float(w.y & 0xffff0000u);
                orow[64 * j] = v * r * gg; } }
    }
}

extern "C" void kernel_launch(void* const* d_in, const int* in_sizes, int n_in, void* d_out, int out_size, void* d_ws, size_t ws_size, hipStream_t stream) {
    static int grid = 0;
    if (grid == 0) {
        if (n_in != 33 || ws_size < WS_END) { fprintf(stderr, "kernel_launch: unexpected n_in %d / ws %zu\n", n_in, ws_size); grid = -1; return; }
        int dev = 0, cus = 0, per_cu = 0;
        hipGetDevice(&dev); hipDeviceGetAttribute(&cus, hipDeviceAttributeMultiprocessorCount, dev);
        if (hipFuncSetAttribute((const void*)mega_fwd, hipFuncAttributeMaxDynamicSharedMemorySize, LDS_BYTES) != hipSuccess) { fprintf(stderr, "hipFuncSetAttribute failed\n"); grid = -1; return; }
        if (hipOccupancyMaxActiveBlocksPerMultiprocessor(&per_cu, (const void*)mega_fwd, NTHR, LDS_BYTES) != hipSuccess || per_cu < 1) { fprintf(stderr, "occupancy query: %d\n", per_cu); per_cu = 1; }
        (void)hipGetLastError();
        grid = cus * 1;
    }
    if (grid < 0) return;
    KP kp{};
    for (int i = 0; i < 33; ++i) kp.in[i] = (const float*)d_in[i];
    kp.out = (float*)d_out; kp.ws = (unsigned char*)d_ws;
    if (hipMemsetAsync(d_ws, 0, 32768, stream) != hipSuccess) { fprintf(stderr, "kernel_launch: memset of barrier words failed\n"); return; }
    void* args[] = {&kp};
    hipError_t e = hipLaunchCooperativeKernel((const void*)mega_fwd, dim3(grid), dim3(NTHR), args, LDS_BYTES, stream);
    if (e != hipSuccess) fprintf(stderr, "cooperative launch failed: %s (grid %d)\n", hipGetErrorString(e), grid);
}
```
